# Optimizing an MI355X kernel written in HIP

```python
import math
import jax, jax.numpy as jnp
from jax import lax
import numpy as np

D_MODEL = 2048
BATCH = 4
SEQ = 4096
DEPTH = 1

HEAD_DIM = 128
A_Q_HEADS = 8
A_KV_HEADS = 2
A_WINDOW = 128
A_BLOCK = 128
B_HEADS = 8
GRID_W = 64
B_WIN_R = 8
B_WIN_C = 16
B_QBLK_R = 8
B_QBLK_C = 16
D_FF = 5632
MACARON_W = 0.5
RMS_EPS = 1e-6
NEG_INF = -1e30

A_Q_W = A_Q_HEADS * HEAD_DIM
A_KV_W = A_KV_HEADS * HEAD_DIM
B_W = B_HEADS * HEAD_DIM
IN_PROJ_W = A_Q_W + 2 * A_KV_W + 3 * B_W + 2 * D_MODEL

kernel_name = "hybrid_window_gqa_natten2d_macaron"


def rms_norm(x, g):
    xf = x.astype(jnp.float32)
    y = xf * lax.rsqrt(jnp.mean(xf * xf, axis=-1, keepdims=True) + RMS_EPS)
    return (y * g.astype(jnp.float32)).astype(x.dtype)


def swiglu_ffn(x, w_in, w_out):
    g, u = jnp.split(x @ w_in, 2, axis=-1)
    return (jax.nn.silu(g) * u) @ w_out


def alibi_slopes(n_heads):
    return np.array([2.0 ** (-8.0 * (i + 1) / n_heads) for i in range(n_heads)], dtype=np.float32)


def windowed_gqa(q, k, v, sink):
    b, s, hq, d = q.shape
    hkv = k.shape[2]
    grp = hq // hkv
    nb = s // A_BLOCK
    nshift = 1 + 2 * (A_WINDOW // A_BLOCK)
    span = nshift * A_BLOCK
    pad = ((0, 0), (A_WINDOW, A_WINDOW), (0, 0), (0, 0))
    kp = jnp.pad(k, pad)
    vp = jnp.pad(v, pad)
    kb = jnp.concatenate([kp[:, j * A_BLOCK: j * A_BLOCK + s].reshape(b, nb, A_BLOCK, hkv, d)
                          for j in range(nshift)], axis=2)
    vb = jnp.concatenate([vp[:, j * A_BLOCK: j * A_BLOCK + s].reshape(b, nb, A_BLOCK, hkv, d)
                          for j in range(nshift)], axis=2)
    qb = q.reshape(b, nb, A_BLOCK, hkv, grp, d)
    scores = jnp.einsum('bnqkgd,bnskd->bnkgqs', qb, kb).astype(jnp.float32) * (d ** -0.5)
    a = np.arange(A_BLOCK)[:, None]
    jj = np.arange(span)[None, :]
    absd = np.abs(a + A_WINDOW - jj).astype(np.float32)
    key_pos = np.arange(nb)[:, None, None] * A_BLOCK - A_WINDOW + jj[None]
    valid = (absd[None] <= A_WINDOW) & (key_pos >= 0) & (key_pos < s)
    slopes = alibi_slopes(hq).reshape(hkv, grp, 1, 1)
    bias = jnp.asarray(-slopes * absd[None, None])
    logits = jnp.where(jnp.asarray(valid)[None, :, None, None], scores + bias[None, None], NEG_INF)
    sink_l = jnp.broadcast_to(sink.astype(jnp.float32).reshape(1, 1, hkv, grp, 1, 1),
                              logits.shape[:-1] + (1,))
    p = jax.nn.softmax(jnp.concatenate([logits, sink_l], axis=-1), axis=-1)[..., :-1]
    out = jnp.einsum('bnkgqs,bnskd->bnqkgd', p.astype(v.dtype), vb)
    return out.reshape(b, s, hq * d)


def neighbourhood_attention_2d(q, k, v, rpb):
    b, s, h, d = q.shape
    rows = s // GRID_W
    kr = min(B_WIN_R, rows)
    kc = min(B_WIN_C, GRID_W)
    qr = math.gcd(rows, B_QBLK_R)
    qc = math.gcd(GRID_W, B_QBLK_C)
    lr = min(qr + kr - 1, rows)
    lc = min(qc + kc - 1, GRID_W)
    nrb = rows // qr
    ncb = GRID_W // qc
    rs = np.clip(np.arange(rows) - kr // 2, 0, rows - kr)
    cs = np.clip(np.arange(GRID_W) - kc // 2, 0, GRID_W - kc)
    key_rows = np.minimum(rs[::qr], rows - lr)[:, None] + np.arange(lr)
    key_cols = np.minimum(cs[::qc], GRID_W - lc)[:, None] + np.arange(lc)
    q_rows = np.arange(nrb)[:, None] * qr + np.arange(qr)
    q_cols = np.arange(ncb)[:, None] * qc + np.arange(qc)
    dr = key_rows[:, None, :] - q_rows[:, :, None]
    dc = key_cols[:, None, :] - q_cols[:, :, None]
    rstart = rs[q_rows][:, :, None]
    cstart = cs[q_cols][:, :, None]
    vr = (key_rows[:, None, :] >= rstart) & (key_rows[:, None, :] < rstart + kr)
    vc = (key_cols[:, None, :] >= cstart) & (key_cols[:, None, :] < cstart + kc)
    full = (nrb, ncb, qr, qc, lr, lc)
    valid = (vr[:, None, :, None, :, None] & vc[None, :, None, :, None, :]).reshape(nrb, ncb, qr * qc, lr * lc)
    ridx = np.broadcast_to(np.clip(dr + B_WIN_R - 1, 0, 2 * B_WIN_R - 2)[:, None, :, None, :, None], full)
    cidx = np.broadcast_to(np.clip(dc + B_WIN_C - 1, 0, 2 * B_WIN_C - 2)[None, :, None, :, None, :], full)
    ridx = ridx.reshape(nrb, ncb, qr * qc, lr * lc)
    cidx = cidx.reshape(nrb, ncb, qr * qc, lr * lc)
    bias = rpb.astype(jnp.float32)[:, ridx, cidx].transpose(1, 2, 0, 3, 4)

    def gather_blocks(t):
        t5 = t.reshape(b, rows, GRID_W, h, d)
        tr = jnp.take(t5, key_rows.reshape(-1), axis=1).reshape(b, nrb, lr, GRID_W, h, d)
        tb = jnp.take(tr, key_cols.reshape(-1), axis=3).reshape(b, nrb, lr, ncb, lc, h, d)
        return tb.transpose(0, 1, 3, 2, 4, 5, 6).reshape(b, nrb, ncb, lr * lc, h, d)

    qg = q.reshape(b, nrb, qr, ncb, qc, h, d).transpose(0, 1, 3, 2, 4, 5, 6).reshape(b, nrb, ncb, qr * qc, h, d)
    kg = gather_blocks(k)
    vg = gather_blocks(v)
    scores = jnp.einsum('bijqhd,bijkhd->bijhqk', qg, kg).astype(jnp.float32) * (d ** -0.5)
    logits = jnp.where(jnp.asarray(valid)[None, :, :, None], scores + bias[None], NEG_INF)
    p = jax.nn.softmax(logits, axis=-1)
    out = jnp.einsum('bijhqk,bijkhd->bijqhd', p.astype(v.dtype), vg)
    out = out.reshape(b, nrb, ncb, qr, qc, h * d).transpose(0, 1, 3, 2, 4, 5)
    return out.reshape(b, s, h * d)


def hybrid_mixer(u, w_in, b_gate, sink_a, rpb_b, w_up_a, w_up_b, w_out):
    b, s, _ = u.shape
    cuts = np.cumsum([A_Q_W, A_KV_W, A_KV_W, B_W, B_W, B_W, D_MODEL]).tolist()
    qa, ka, va, qb, kb, vb, ga, gb = jnp.split(u @ w_in, cuts, axis=-1)
    bga, bgb = jnp.split(b_gate, 2)
    ya = windowed_gqa(qa.reshape(b, s, A_Q_HEADS, HEAD_DIM),
                      ka.reshape(b, s, A_KV_HEADS, HEAD_DIM),
                      va.reshape(b, s, A_KV_HEADS, HEAD_DIM), sink_a) @ w_up_a
    yb = neighbourhood_attention_2d(qb.reshape(b, s, B_HEADS, HEAD_DIM),
                                    kb.reshape(b, s, B_HEADS, HEAD_DIM),
                                    vb.reshape(b, s, B_HEADS, HEAD_DIM), rpb_b) @ w_up_b
    m = jax.nn.sigmoid(ga + bga) * ya + jax.nn.sigmoid(gb + bgb) * yb
    return m @ w_out


def setup_inputs(seed: int = 0) -> dict:
    key = jax.random.key(seed)
    ks = jax.random.split(key, 20)
    f32 = jnp.float32

    def w(k, shape, fan_in):
        return jax.random.normal(k, shape, f32) * (fan_in ** -0.5)

    def gain(k):
        return 1.0 + 0.05 * jax.random.normal(k, (DEPTH, D_MODEL), f32)

    return {
        "x": jax.random.normal(ks[0], (BATCH, SEQ, D_MODEL), f32),
        "ffn1_pre_g": gain(ks[1]),
        "ffn1_w_in": w(ks[2], (DEPTH, D_MODEL, 2 * D_FF), D_MODEL),
        "ffn1_w_out": w(ks[3], (DEPTH, D_FF, D_MODEL), D_FF),
        "ffn1_post_g": gain(ks[4]),
        "mix_pre_g": gain(ks[5]),
        "w_in": w(ks[6], (DEPTH, D_MODEL, IN_PROJ_W), D_MODEL),
        "b_gate": 0.01 * jax.random.normal(ks[7], (DEPTH, 2 * D_MODEL), f32),
        "sink_a": jax.random.normal(ks[8], (DEPTH, A_Q_HEADS), f32),
        "rpb_b": 0.02 * jax.random.normal(ks[9], (DEPTH, B_HEADS, 2 * B_WIN_R - 1, 2 * B_WIN_C - 1), f32),
        "w_up_a": w(ks[10], (DEPTH, A_Q_W, D_MODEL), A_Q_W),
        "w_up_b": w(ks[11], (DEPTH, B_W, D_MODEL), B_W),
        "w_out": w(ks[12], (DEPTH, D_MODEL, D_MODEL), D_MODEL),
        "mix_post_g": gain(ks[13]),
        "ffn2_pre_g": gain(ks[14]),
        "ffn2_w_in": w(ks[15], (DEPTH, D_MODEL, 2 * D_FF), D_MODEL),
        "ffn2_w_out": w(ks[16], (DEPTH, D_FF, D_MODEL), D_FF),
        "ffn2_post_g": gain(ks[17]),
    }


def reference(x, ffn1_pre_g, ffn1_w_in, ffn1_w_out, ffn1_post_g, mix_pre_g, w_in, b_gate, sink_a,
              rpb_b, w_up_a, w_up_b, w_out, mix_post_g, ffn2_pre_g, ffn2_w_in, ffn2_w_out, ffn2_post_g):
    h = x
    for l in range(DEPTH):
        f1 = swiglu_ffn(rms_norm(h, ffn1_pre_g[l]), ffn1_w_in[l], ffn1_w_out[l])
        h = h + MACARON_W * rms_norm(f1, ffn1_post_g[l])
        mix = hybrid_mixer(rms_norm(h, mix_pre_g[l]), w_in[l], b_gate[l], sink_a[l], rpb_b[l],
                           w_up_a[l], w_up_b[l], w_out[l])
        h = h + rms_norm(mix, mix_post_g[l])
        f2 = swiglu_ffn(rms_norm(h, ffn2_pre_g[l]), ffn2_w_in[l], ffn2_w_out[l])
        h = h + MACARON_W * rms_norm(f2, ffn2_post_g[l])
    return h
```

```cpp
#include <hip/hip_runtime.h>
#include <hip/hip_cooperative_groups.h>
#include <cstdio>
#include <cstdint>
#include <cmath>
namespace cg = cooperative_groups;
namespace pg8 {
#define PG8_LAS __attribute__((address_space(3)))
typedef unsigned short bf16_t;
typedef short bf16x8 __attribute__((ext_vector_type(8)));
typedef float f32x4 __attribute__((ext_vector_type(4)));
typedef unsigned u32x4 __attribute__((ext_vector_type(4)));
constexpr int BM = 256, BK = 64, HALF = 128, HTB = HALF * BK * 2  , STAGE_BYTES = 8 * HTB, NXCD = 8, WGM = 8;

__host__ __device__ __forceinline__ int lds_byte(int r, int c) { const int st = (r >> 4) * 2 + (c >> 5), rr = r & 15, cc = c & 31, ob = rr * 64 + cc * 2; return st * 1024 + (ob ^ (((ob >> 9) & 1) << 5)); }
__host__ __device__ __forceinline__ void stage_rc(int b, int& R, int& C) { const int st = b / 1024, sb = b % 1024, swz = sb ^ (((sb >> 9) & 1) << 5); R = (st >> 1) * 16 + swz / 64; C = (st & 1) * 32 + (swz % 64) / 2; }
__host__ __device__ __forceinline__ int perm32(int rho) { const int n = rho >> 4, i = rho & 15; return 8 * (i >> 2) + 4 * n + (i & 3); }

struct Unit { int pm, pn; };
struct Gemm { const bf16_t* A; const bf16_t* Bt; int M, N, K, lda; };

struct StaticOrder {
    int nM, nN, nwg, G, c, rep;
    __host__ __device__ void init(int M, int N, int G_, int c_, int rep_ = 1) { nM = M / BM; nN = N / BM; nwg = nM * nN; G = G_; c = c_; rep = rep_; }
    __host__ __device__ bool next(int i, Unit& u) const {
        long L = (long)i * G + c; if (L >= (long)nwg * rep) return false; L %= nwg;
        int wgid = (int)L; { const int q = nwg / NXCD, r = nwg % NXCD, xcd = wgid % NXCD, off = wgid / NXCD; wgid = (xcd < r ? xcd * (q + 1) : r * (q + 1) + (xcd - r) * q) + off; }
        const int nig = WGM * nN, gid = wgid / nig, fm = gid * WGM, gsz = (nM - fm) < WGM ? (nM - fm) : WGM;
        u.pm = fm + ((wgid % nig) % gsz); u.pn = (wgid % nig) / gsz; return true;
    }
    __device__ __forceinline__ void a_ready(const Unit&) const {}
    __device__ __forceinline__ void done(const Unit&) const {}
};

__device__ __forceinline__ unsigned cvt_pk_bf16(float lo, float hi) { unsigned r; asm volatile("v_cvt_pk_bf16_f32 %0, %1, %2" : "=v"(r) : "v"(lo), "v"(hi)); return r; }
typedef float f32x2 __attribute__((ext_vector_type(2)));
__device__ __forceinline__ float bflo(unsigned u) { return __uint_as_float(u << 16); }
__device__ __forceinline__ float bfhi(unsigned u) { return __uint_as_float(u & 0xffff0000u); }
__device__ __forceinline__ float sigmoid_f(float x) { return __builtin_amdgcn_rcpf(1.0f + __builtin_amdgcn_exp2f(-1.4426950408889634f * x)); }

struct EpiStore {
    static constexpr bool PERM = true, AFTER_DRAIN = false, MID = false; static constexpr int NSTORE = 16;
    bf16_t* O; int ldc;
    __device__ __forceinline__ void operator()(const f32x4 (&acc)[2][2][4][2], const Unit& u, int wr, int wc, int fr, int fq) const {
        const int row0 = u.pm * BM + wr * 64 + fr, col0 = u.pn * BM + wc * 32 + 8 * fq;
#pragma unroll
        for (int ai = 0; ai < 2; ++ai)
#pragma unroll
            for (int m = 0; m < 4; ++m) { bf16_t* rowp = O + (size_t)(row0 + ai * HALF + m * 16) * ldc + col0;
#pragma unroll
                for (int bj = 0; bj < 2; ++bj) { const f32x4 v0 = acc[ai][bj][m][0], v1 = acc[ai][bj][m][1];
                    u32x4 w; w.x = cvt_pk_bf16(v0[0], v0[1]); w.y = cvt_pk_bf16(v0[2], v0[3]); w.z = cvt_pk_bf16(v1[0], v1[1]); w.w = cvt_pk_bf16(v1[2], v1[3]);
                    *(u32x4*)(rowp + bj * HALF) = w; } }
    }
};

struct EpiSwiGLU {
    static constexpr bool PERM = true, AFTER_DRAIN = false, MID = false; static constexpr int NSTORE = 8;
    bf16_t* O; int ldc;
    __device__ __forceinline__ void operator()(const f32x4 (&acc)[2][2][4][2], const Unit& u, int wr, int wc, int fr, int fq) const {
        const int row0 = u.pm * BM + wr * 64 + fr, col0 = u.pn * HALF + wc * 32 + 8 * fq;
#pragma unroll
        for (int ai = 0; ai < 2; ++ai)
#pragma unroll
            for (int m = 0; m < 4; ++m) { bf16_t* rowp = O + (size_t)(row0 + ai * HALF + m * 16) * ldc + col0;
                float r[8];
#pragma unroll
                for (int n = 0; n < 2; ++n)
#pragma unroll
                    for (int j = 0; j < 4; j += 2) {
                        const f32x2 g = (f32x2){acc[ai][0][m][n][j], acc[ai][0][m][n][j + 1]}, uu = (f32x2){acc[ai][1][m][n][j], acc[ai][1][m][n][j + 1]};
                        const f32x2 t = g * (-1.4426950408889634f); f32x2 e; e.x = __builtin_amdgcn_exp2f(t.x); e.y = __builtin_amdgcn_exp2f(t.y);
                        const f32x2 d = e + 1.0f; f32x2 q; q.x = __builtin_amdgcn_rcpf(d.x); q.y = __builtin_amdgcn_rcpf(d.y);
                        const f32x2 o = (g * uu) * q; r[4 * n + j] = o.x; r[4 * n + j + 1] = o.y; }
                u32x4 w; w.x = cvt_pk_bf16(r[0], r[1]); w.y = cvt_pk_bf16(r[2], r[3]); w.z = cvt_pk_bf16(r[4], r[5]); w.w = cvt_pk_bf16(r[6], r[7]);
                *(u32x4*)rowp = w; }
    }
};

struct EpiInProj {
    static constexpr bool PERM = true, AFTER_DRAIN = false, MID = false; static constexpr int NSTORE = 16;
    bf16_t* O; int ldc; const float* bias; int gate_tile0;
    __device__ __forceinline__ void operator()(const f32x4 (&acc)[2][2][4][2], const Unit& u, int wr, int wc, int fr, int fq) const {
        const int row0 = u.pm * BM + wr * 64 + fr, col0 = u.pn * BM + wc * 32 + 8 * fq;
        const bool gate = u.pn >= gate_tile0;
        f32x4 bv[2][2];
#pragma unroll
        for (int bj = 0; bj < 2; ++bj)
#pragma unroll
            for (int n = 0; n < 2; ++n) bv[bj][n] = gate ? *(const f32x4*)(bias + (col0 - gate_tile0 * BM) + bj * HALF + 4 * n) : (f32x4){0.f, 0.f, 0.f, 0.f};
#pragma unroll
        for (int ai = 0; ai < 2; ++ai)
#pragma unroll
            for (int m = 0; m < 4; ++m) { bf16_t* rowp = O + (size_t)(row0 + ai * HALF + m * 16) * ldc + col0;
#pragma unroll
                for (int bj = 0; bj < 2; ++bj) { f32x4 v0 = acc[ai][bj][m][0], v1 = acc[ai][bj][m][1];
                    if (gate) {
                        const f32x4 t0 = (v0 + bv[bj][0]) * (-1.4426950408889634f), t1 = (v1 + bv[bj][1]) * (-1.4426950408889634f);
                        f32x4 e0, e1;
#pragma unroll
                        for (int j = 0; j < 4; ++j) { e0[j] = __builtin_amdgcn_exp2f(t0[j]); e1[j] = __builtin_amdgcn_exp2f(t1[j]); }
                        e0 = e0 + 1.0f; e1 = e1 + 1.0f;
#pragma unroll
                        for (int j = 0; j < 4; ++j) { v0[j] = __builtin_fmaxf(__builtin_amdgcn_rcpf(e0[j]), 9.5367431640625e-07f); v1[j] = __builtin_fmaxf(__builtin_amdgcn_rcpf(e1[j]), 9.5367431640625e-07f); } }
                    u32x4 w; w.x = cvt_pk_bf16(v0[0], v0[1]); w.y = cvt_pk_bf16(v0[2], v0[3]); w.z = cvt_pk_bf16(v1[0], v1[1]); w.w = cvt_pk_bf16(v1[2], v1[3]);
                    *(u32x4*)(rowp + bj * HALF) = w; } }
    }
};

struct EpiUp {
    static constexpr bool PERM = true, AFTER_DRAIN = false, MID = true; static constexpr int NSTORE = 16;
    bf16_t* O; int ldc; const bf16_t* G; int ldg, ga_col, gb_col, kmid;
    __device__ __forceinline__ void mid(f32x4 (&acc)[2][2][4][2], const Unit& u, int wr, int wc, int fr, int fq) const {
        const int row0 = u.pm * BM + wr * 64 + fr, col0 = u.pn * BM + wc * 32 + 8 * fq;
        unsigned off = (unsigned)row0 * (unsigned)ldg + (unsigned)col0; asm volatile("" : "+v"(off));
#pragma unroll
        for (int ai = 0; ai < 2; ++ai)
#pragma unroll
            for (int m = 0; m < 4; ++m) { const bf16_t* gp = G + (off + (unsigned)((ai * HALF + m * 16) * ldg));
#pragma unroll
                for (int bj = 0; bj < 2; ++bj) { const u32x4 a = *(const u32x4*)(gp + ga_col + bj * HALF), b = *(const u32x4*)(gp + gb_col + bj * HALF);
                    f32x4 r0, r1;
                    r0[0] = bflo(a.x) * __builtin_amdgcn_rcpf(bflo(b.x)); r0[1] = bfhi(a.x) * __builtin_amdgcn_rcpf(bfhi(b.x));
                    r0[2] = bflo(a.y) * __builtin_amdgcn_rcpf(bflo(b.y)); r0[3] = bfhi(a.y) * __builtin_amdgcn_rcpf(bfhi(b.y));
                    r1[0] = bflo(a.z) * __builtin_amdgcn_rcpf(bflo(b.z)); r1[1] = bfhi(a.z) * __builtin_amdgcn_rcpf(bfhi(b.z));
                    r1[2] = bflo(a.w) * __builtin_amdgcn_rcpf(bflo(b.w)); r1[3] = bfhi(a.w) * __builtin_amdgcn_rcpf(bfhi(b.w));
                    acc[ai][bj][m][0] *= r0; acc[ai][bj][m][1] *= r1; }
                asm volatile("" ::: "memory"); }
    }
    __device__ __forceinline__ void operator()(const f32x4 (&acc)[2][2][4][2], const Unit& u, int wr, int wc, int fr, int fq) const {
        const int row0 = u.pm * BM + wr * 64 + fr, col0 = u.pn * BM + wc * 32 + 8 * fq;
#pragma unroll
        for (int ai = 0; ai < 2; ++ai)
#pragma unroll
            for (int m = 0; m < 4; ++m) { const size_t row = (size_t)(row0 + ai * HALF + m * 16); const bf16_t* gp = G + row * ldg + col0 + gb_col; bf16_t* rowp = O + row * ldc + col0;
#pragma unroll
                for (int bj = 0; bj < 2; ++bj) { const u32x4 b = *(const u32x4*)(gp + bj * HALF); const f32x4 v0 = acc[ai][bj][m][0], v1 = acc[ai][bj][m][1];
                    u32x4 w; w.x = cvt_pk_bf16(v0[0] * bflo(b.x), v0[1] * bfhi(b.x)); w.y = cvt_pk_bf16(v0[2] * bflo(b.y), v0[3] * bfhi(b.y));
                    w.z = cvt_pk_bf16(v1[0] * bflo(b.z), v1[1] * bfhi(b.z)); w.w = cvt_pk_bf16(v1[2] * bflo(b.w), v1[3] * bfhi(b.w));
                    *(u32x4*)(rowp + bj * HALF) = w; }
                asm volatile("" ::: "memory"); }
    }
};

template <class Epi, class Sched, bool ALIGN_EPI = false, bool SP2 = false>
__device__ __forceinline__ void gemm_phase(PG8_LAS unsigned char* lds, const Gemm g, const Sched& S, const Epi& E) {
    const int tid = threadIdx.x, wid = __builtin_amdgcn_readfirstlane(tid >> 6), lane = tid & 63, wr = wid >> 2, wc = wid & 3, fr = lane & 15, fq = lane >> 4;
    const int K = g.K, nt = K / BK, lda = g.lda ? g.lda : K;
    unsigned voffA[2], voffB[2];
#pragma unroll
    for (int i = 0; i < 2; ++i) { int R, C; stage_rc(tid * 16 + i * 8192, R, C); const int Rb = Epi::PERM ? ((R & ~31) + perm32(R & 31)) : R;
        voffA[i] = (unsigned)(R * lda + C) * 2u; voffB[i] = (unsigned)(Rb * K + C) * 2u; }
    const size_t kstep = (size_t)(BK * 2);
    const size_t hstep = (size_t)HALF * K * 2;
    const size_t tstep = 2 * hstep;
    const size_t hstepA = (size_t)HALF * lda * 2, tstepA = 2 * hstepA;
    const unsigned ldsw = (unsigned)wid * 1024u;
    const int aoff = lds_byte(wr * 64 + fr, fq * 8), boff = lds_byte(wc * 32 + fr, fq * 8);
#define PG8_SA(b, h) (((b) * 2 + (h)) * HTB)
#define PG8_SB(b, h) ((4 + (b) * 2 + (h)) * HTB)
#define PG8_STAGE(bufoff, gbase, voff) do { _Pragma("unroll") for (int _i = 0; _i < 2; ++_i) \
        __builtin_amdgcn_global_load_lds((const unsigned*)((const char*)(gbase) + (voff)[_i]), (PG8_LAS unsigned*)(lds + (bufoff) + ldsw + _i * 8192), 16, 0, 0); } while (0)
#define PG8_LDA(dst, b, h) do { _Pragma("unroll") for (int m = 0; m < 4; ++m) _Pragma("unroll") for (int k = 0; k < 2; ++k) dst[m][k] = *(const PG8_LAS bf16x8*)(lds + PG8_SA(b, h) + aoff + m * 2048 + k * 1024); } while (0)
#define PG8_LDB(dst, b, h) do { _Pragma("unroll") for (int n = 0; n < 2; ++n) _Pragma("unroll") for (int k = 0; k < 2; ++k) dst[n][k] = *(const PG8_LAS bf16x8*)(lds + PG8_SB(b, h) + boff + n * 2048 + k * 1024); } while (0)
#define PG8_MMA(ai, bj, At, Bt) do { __builtin_amdgcn_s_setprio(1); _Pragma("unroll") for (int m = 0; m < 4; ++m) _Pragma("unroll") for (int n = 0; n < 2; ++n) _Pragma("unroll") for (int k = 0; k < 2; ++k) \
        acc[ai][bj][m][n] = __builtin_amdgcn_mfma_f32_16x16x32_bf16(Bt[n][k], At[m][k], acc[ai][bj][m][n], 0, 0, 0); __builtin_amdgcn_s_setprio(0); } while (0)
#define PG8_WAIT_V(n) asm volatile("s_waitcnt vmcnt(" #n ")" ::: "memory")
#define PG8_WAIT_L(n) asm volatile("s_waitcnt lgkmcnt(" #n ")" ::: "memory")
#define PG8_BAR __builtin_amdgcn_s_barrier()
#define PG8_SCHED __builtin_amdgcn_sched_barrier(0)
    Unit cur, nxt; int ui = 0;
    if (!S.next(0, cur)) return;
    f32x4 acc[2][2][4][2];
#pragma unroll
    for (int a = 0; a < 2; ++a)
#pragma unroll
        for (int b = 0; b < 2; ++b)
#pragma unroll
            for (int m = 0; m < 4; ++m)
#pragma unroll
                for (int n = 0; n < 2; ++n) acc[a][b][m][n] = (f32x4){0.f, 0.f, 0.f, 0.f};
    bf16x8 At[4][2], B0[2][2], B1[2][2];
    const char* cA = (const char*)g.A + (size_t)cur.pm * tstepA; const char* cB = (const char*)g.Bt + (size_t)cur.pn * tstep;
    S.a_ready(cur);
    if constexpr (SP2) {
        PG8_STAGE(PG8_SB(0, 0), cB, voffB); PG8_STAGE(PG8_SB(0, 1), cB + hstep, voffB); PG8_STAGE(PG8_SA(0, 0), cA, voffA); PG8_STAGE(PG8_SA(0, 1), cA + hstepA, voffA);
        if (wr == 1) PG8_BAR;
        PG8_WAIT_V(2); PG8_BAR;
        PG8_STAGE(PG8_SB(1, 0), cB + kstep, voffB); PG8_STAGE(PG8_SA(1, 0), cA + kstep, voffA); PG8_STAGE(PG8_SB(1, 1), cB + hstep + kstep, voffB);
        PG8_WAIT_V(6); PG8_BAR;
    } else {
        PG8_STAGE(PG8_SB(0, 0), cB, voffB); PG8_STAGE(PG8_SA(0, 0), cA, voffA); PG8_STAGE(PG8_SB(0, 1), cB + hstep, voffB); PG8_STAGE(PG8_SA(0, 1), cA + hstepA, voffA);
        if (wr == 1) PG8_BAR;
        PG8_WAIT_V(4); PG8_BAR;
        PG8_STAGE(PG8_SB(1, 0), cB + kstep, voffB); PG8_STAGE(PG8_SA(1, 0), cA + kstep, voffA); PG8_STAGE(PG8_SB(1, 1), cB + hstep + kstep, voffB);
        PG8_WAIT_V(6); PG8_BAR;
    }
    for (;;) {
        const bool has_next = S.next(ui + 1, nxt);
        const char* nA = has_next ? (const char*)g.A + (size_t)nxt.pm * tstepA : cA; const char* nB = has_next ? (const char*)g.Bt + (size_t)nxt.pn * tstep : cB;
        for (int t = 0; t < nt; t += 2) {
            if constexpr (Epi::MID) { if (t == E.kmid) E.mid(acc, cur, wr, wc, fr, fq); }
            const bool last = (t == nt - 2);
            const char* a1 = cA + (size_t)(t + 1) * kstep;
            const char* a2 = last ? nA : cA + (size_t)(t + 2) * kstep; const char* b2 = last ? nB : cB + (size_t)(t + 2) * kstep;
            const char* a3 = a2 + kstep; const char* b3 = b2 + kstep;
            if (last && has_next) S.a_ready(nxt);
            if constexpr (SP2) {
            const int relax = __builtin_amdgcn_readfirstlane(((t == 0) && (ui > 0)) ? 1 : 0);
            PG8_LDB(B0, 0, 0); PG8_LDB(B1, 0, 1); PG8_SCHED; PG8_LDA(At, 0, 0); PG8_STAGE(PG8_SA(1, 1), a1 + hstepA, voffA);
            asm volatile("s_cmp_eq_u32 %0, 0\n\ts_cbranch_scc1 1f\n\ts_waitcnt vmcnt(%1)\n\ts_branch 2f\n1:\n\ts_waitcnt vmcnt(8)\n2:" :: "s"(relax), "n"(8 + Epi::NSTORE) : "memory", "scc");
            PG8_WAIT_L(0); PG8_BAR; PG8_MMA(0, 0, At, B0); PG8_MMA(0, 1, At, B1); PG8_BAR; PG8_SCHED;
            PG8_LDA(At, 0, 1); PG8_STAGE(PG8_SB(0, 0), b2, voffB); PG8_STAGE(PG8_SB(0, 1), b2 + hstep, voffB); PG8_STAGE(PG8_SA(0, 0), a2, voffA);
            asm volatile("s_cmp_eq_u32 %0, 0\n\ts_cbranch_scc1 1f\n\ts_waitcnt vmcnt(%1)\n\ts_branch 2f\n1:\n\ts_waitcnt vmcnt(8)\n2:" :: "s"(relax), "n"(8 + Epi::NSTORE) : "memory", "scc");
            PG8_WAIT_L(0); PG8_BAR; PG8_MMA(1, 0, At, B0); PG8_MMA(1, 1, At, B1); PG8_BAR; PG8_SCHED;
            PG8_LDB(B0, 1, 0); PG8_LDB(B1, 1, 1); PG8_SCHED; PG8_LDA(At, 1, 0); PG8_STAGE(PG8_SA(0, 1), a2 + hstepA, voffA);
            PG8_WAIT_V(8); PG8_WAIT_L(0); PG8_BAR; PG8_MMA(0, 0, At, B0); PG8_MMA(0, 1, At, B1); PG8_BAR; PG8_SCHED;
            PG8_LDA(At, 1, 1); PG8_STAGE(PG8_SB(1, 0), b3, voffB); PG8_STAGE(PG8_SB(1, 1), b3 + hstep, voffB); PG8_STAGE(PG8_SA(1, 0), a3, voffA);
            PG8_WAIT_V(8); PG8_WAIT_L(0); PG8_BAR; PG8_MMA(1, 0, At, B0); PG8_MMA(1, 1, At, B1); PG8_BAR; PG8_SCHED;
            } else {
            PG8_LDB(B0, 0, 0); PG8_SCHED; PG8_LDA(At, 0, 0); PG8_STAGE(PG8_SA(1, 1), a1 + hstepA, voffA);
            PG8_WAIT_L(8); PG8_BAR; PG8_WAIT_L(0); PG8_MMA(0, 0, At, B0); PG8_BAR; PG8_SCHED;
            PG8_LDB(B1, 0, 1); PG8_STAGE(PG8_SB(0, 0), b2, voffB);
            PG8_BAR; PG8_WAIT_L(0); PG8_MMA(0, 1, At, B1); PG8_BAR;
            PG8_LDA(At, 0, 1); PG8_STAGE(PG8_SA(0, 0), a2, voffA);
            PG8_BAR; PG8_WAIT_L(0); PG8_MMA(1, 0, At, B0); PG8_BAR; PG8_SCHED;
            PG8_STAGE(PG8_SB(0, 1), b2 + hstep, voffB);
            PG8_WAIT_V(6); PG8_BAR; PG8_MMA(1, 1, At, B1); PG8_BAR;
            PG8_LDB(B0, 1, 0); PG8_SCHED; PG8_LDA(At, 1, 0); PG8_STAGE(PG8_SA(0, 1), a2 + hstepA, voffA);
            PG8_WAIT_L(8); PG8_BAR; PG8_WAIT_L(0); PG8_MMA(0, 0, At, B0); PG8_BAR; PG8_SCHED;
            PG8_LDB(B1, 1, 1); PG8_STAGE(PG8_SB(1, 0), b3, voffB);
            PG8_BAR; PG8_WAIT_L(0); PG8_MMA(0, 1, At, B1); PG8_BAR;
            PG8_LDA(At, 1, 1); PG8_STAGE(PG8_SA(1, 0), a3, voffA);
            PG8_BAR; PG8_WAIT_L(0); PG8_MMA(1, 0, At, B0); PG8_BAR; PG8_SCHED;
            PG8_STAGE(PG8_SB(1, 1), b3 + hstep, voffB);
            PG8_WAIT_V(6); PG8_BAR; PG8_MMA(1, 1, At, B1); PG8_BAR;
            }
        }
        if constexpr (ALIGN_EPI) { if (wr == 0) PG8_BAR; }
        if constexpr (!Epi::AFTER_DRAIN) { E(acc, cur, wr, wc, fr, fq); S.done(cur); }
        if (!has_next) break;
#pragma unroll
        for (int a = 0; a < 2; ++a)
#pragma unroll
            for (int b = 0; b < 2; ++b)
#pragma unroll
                for (int m = 0; m < 4; ++m)
#pragma unroll
                    for (int n = 0; n < 2; ++n) acc[a][b][m][n] = (f32x4){0.f, 0.f, 0.f, 0.f};
        cur = nxt; cA = nA; cB = nB; ++ui;
        if constexpr (ALIGN_EPI) { if (wr == 1) PG8_BAR; }
    }
    PG8_WAIT_V(0);
    if constexpr (!ALIGN_EPI) { if (wr == 0) PG8_BAR; }
    PG8_BAR;
    if constexpr (Epi::AFTER_DRAIN) { E.fused(acc, cur, wr, wc, fr, fq, lds, wid, lane); S.done(cur); }
#undef PG8_SA
#undef PG8_SB
#undef PG8_STAGE
#undef PG8_LDA
#undef PG8_LDB
#undef PG8_MMA
#undef PG8_WAIT_V
#undef PG8_WAIT_L
#undef PG8_BAR
#undef PG8_SCHED
}
}

constexpr int NWAVES = 8;
constexpr int BATCH = 4, SEQ = 4096, DM = 2048, M = BATCH * SEQ, DFF = 5632, NIN = 8704;
constexpr int GATE_COL = 4608;
constexpr float RMS_EPS = 1e-6f;
#ifndef MK_MULTI
#define MK_MULTI 0
#endif
constexpr int N_PHASES = 12;
#ifndef PG8_SP2
#define PG8_SP2 true
#endif
#ifndef PG8_ALIGN
#define PG8_ALIGN true
#endif

constexpr size_t MiB = 1u << 20;
constexpr size_t WS_BAR = 4096, WS_BAR_BYTES = 16384;
constexpr size_t WS_RS = 65536;
constexpr size_t WS_W = 1 * MiB;
constexpr size_t WS_XN = 67 * MiB;
constexpr size_t WS_F = 131 * MiB;
constexpr size_t WS_R1 = 195 * MiB;
constexpr size_t WS_END = 467 * MiB;
constexpr size_t W_FFN_IN = 0, W_FFN_OUT = 44 * MiB;
constexpr size_t W_MIX_IN = 0, W_MIX_UP = 34 * MiB, W_MIX_OUT = 42 * MiB;

constexpr int RING_BYTES = 131072;
constexpr int LDS_BYTES = 147456;

#define GAS __attribute__((address_space(1)))
#define LAS __attribute__((address_space(3)))
typedef unsigned short bf16;
typedef unsigned v4u __attribute__((ext_vector_type(4)));
typedef unsigned v2u __attribute__((ext_vector_type(2)));
typedef float f32x4 __attribute__((ext_vector_type(4)));
typedef float f32x16 __attribute__((ext_vector_type(16)));
typedef short bf16x8 __attribute__((ext_vector_type(8)));
typedef short v4i16_t __attribute__((ext_vector_type(4)));
#define LDS_WAIT() asm volatile("s_waitcnt lgkmcnt(0)" ::: "memory")

__device__ __forceinline__ unsigned f2bf(float f) { unsigned u = __builtin_bit_cast(unsigned, f); return (u + 0x7fffu + ((u >> 16) & 1u)) >> 16; }
__device__ __forceinline__ unsigned pk2(float lo, float hi) { return f2bf(lo) | (f2bf(hi) << 16); }
__device__ __forceinline__ float wave_sum(float v) {
#pragma unroll
    for (int o = 1; o < 64; o <<= 1) v += __shfl_xor(v, o);
    return v;
}

__device__ __forceinline__ void tr_item(const float* W, int N, bf16* WT, int Kdst, int kdst0, bool swiglu, const float* gain, LAS float* scr, int item, int lane) {
    const int nblk = N / 32, kb = item / nblk, nb = item % nblk, k0 = 64 * kb, nd0 = 32 * nb;
    int ns0 = nd0;
    if (swiglu) { const int t = nd0 >> 8, w = nd0 & 255; ns0 = (w < 128) ? t * 128 + w : (N / 2) + t * 128 + (w - 128); }
    float wv[32];
    const float* wp = W + (size_t)(k0 + (lane >> 5)) * N + ns0 + (lane & 31);
#pragma unroll
    for (int i = 0; i < 32; ++i) wv[i] = __builtin_nontemporal_load(wp + (size_t)(2 * i) * N);
#pragma unroll
    for (int i = 0; i < 32; ++i) scr[(2 * i + (lane >> 5)) * 33 + (lane & 31)] = wv[i];
    LDS_WAIT(); asm volatile("" ::: "memory");
    const int c = lane & 7;
    f32x4 g0 = (f32x4){1.f, 1.f, 1.f, 1.f}, g1 = g0;
    if (gain) { g0 = *(const f32x4*)(gain + k0 + 8 * c); g1 = *(const f32x4*)(gain + k0 + 8 * c + 4); }
#pragma unroll
    for (int j = 0; j < 4; ++j) { const int n = (lane >> 3) + 8 * j; const LAS float* s = scr + (8 * c) * 33 + n;
        v4u o; o.x = pk2(s[0 * 33] * g0.x, s[1 * 33] * g0.y); o.y = pk2(s[2 * 33] * g0.z, s[3 * 33] * g0.w); o.z = pk2(s[4 * 33] * g1.x, s[5 * 33] * g1.y); o.w = pk2(s[6 * 33] * g1.z, s[7 * 33] * g1.w);
        *(GAS v4u*)(WT + (size_t)(nd0 + n) * Kdst + kdst0 + k0 + 8 * c) = o; }
    LDS_WAIT(); asm volatile("" ::: "memory");
}
struct TrMat { const float* W; int Ksrc, N; bf16* WT; int Kdst, kdst0; bool swiglu; const float* gain; };
__device__ __forceinline__ void tr_run(const TrMat& t, LAS float* scr, int gw, int NGW, int lane, int part = 0, int nparts = 1) {
    const int items = (t.Ksrc / 64) * (t.N / 32), i0 = (int)((long)items * part / nparts), i1 = (int)((long)items * (part + 1) / nparts);
    for (int it = i0 + gw; it < i1; it += NGW) tr_item(t.W, t.N, t.WT, t.Kdst, t.kdst0, t.swiglu, t.gain, scr, it, lane);
}

__device__ __forceinline__ void tr_run_dyn(const TrMat& t, LAS float* scr, unsigned* ctr, volatile LAS unsigned* slot, int wave, int lane, int tid, int part, int nparts, int span) {
    const int items = (t.Ksrc / 64) * (t.N / 32), i0 = (int)((long)items * part / nparts), i1 = (int)((long)items * (part + span) / nparts);
    unsigned nxt = 0u;
    if (tid == 0) nxt = __hip_atomic_fetch_add(ctr, 8u, __ATOMIC_RELAXED, __HIP_MEMORY_SCOPE_AGENT);
    for (;;) {
        if (tid == 0) slot[0] = nxt;
        __syncthreads();
        const int base = i0 + (int)slot[0];
        if (base >= i1) break;
        if (tid == 0) nxt = __hip_atomic_fetch_add(ctr, 8u, __ATOMIC_RELAXED, __HIP_MEMORY_SCOPE_AGENT);
        const int it = base + wave;
        if (it < i1) tr_item(t.W, t.N, t.WT, t.Kdst, t.kdst0, t.swiglu, t.gain, scr, it, lane);
        __syncthreads();
    }
    __syncthreads();
}

__device__ __forceinline__ void norm_rows(int m0, int mstride, int mend, int lane, const float* hx, const bf16* hb_in, const bf16* f, const float* gpost, float wres, bf16* hb_out, float* rs, float* fout) {
    for (int m = m0; m < mend; m += mstride) {
        f32x4 v[8];
        if (hx) { const GAS f32x4* hr = (const GAS f32x4*)(hx + (size_t)m * DM) + lane;
#pragma unroll
            for (int j = 0; j < 8; ++j) v[j] = __builtin_nontemporal_load(hr + 64 * j);
        } else { const GAS v2u* hr = (const GAS v2u*)(hb_in + (size_t)m * DM) + lane;
            const float un = 1.0f / rs[m];
#pragma unroll
            for (int j = 0; j < 8; ++j) { const v2u w = __builtin_nontemporal_load(hr + 64 * j); v[j] = (f32x4){__uint_as_float(w.x << 16), __uint_as_float(w.x & 0xffff0000u), __uint_as_float(w.y << 16), __uint_as_float(w.y & 0xffff0000u)} * un; }
        }
        if (f) {
            const GAS v2u* fr = (const GAS v2u*)(f + (size_t)m * DM) + lane;
            f32x4 fv[8]; float ss = 0.f;
#pragma unroll
            for (int j = 0; j < 8; ++j) { const v2u w = __builtin_nontemporal_load(fr + 64 * j); fv[j] = (f32x4){__uint_as_float(w.x << 16), __uint_as_float(w.x & 0xffff0000u), __uint_as_float(w.y << 16), __uint_as_float(w.y & 0xffff0000u)};
                ss += (fv[j].x * fv[j].x + fv[j].y * fv[j].y) + (fv[j].z * fv[j].z + fv[j].w * fv[j].w); }
            const float rstd = wres * __builtin_amdgcn_rsqf(wave_sum(ss) * (1.f / DM) + RMS_EPS);
#pragma unroll
            for (int j = 0; j < 8; ++j) { const f32x4 g = *((const GAS f32x4*)gpost + lane + 64 * j); v[j] = v[j] + fv[j] * rstd * g; }
        }
        if (fout) { GAS f32x4* ho = (GAS f32x4*)(fout + (size_t)m * DM) + lane;
#pragma unroll
            for (int j = 0; j < 8; ++j) __builtin_nontemporal_store(v[j], ho + 64 * j);
        } else {
            float ss = 0.f;
#pragma unroll
            for (int j = 0; j < 8; ++j) ss += (v[j].x * v[j].x + v[j].y * v[j].y) + (v[j].z * v[j].z + v[j].w * v[j].w);
            const float rstd = __builtin_amdgcn_rsqf(wave_sum(ss) * (1.f / DM) + RMS_EPS);
            if (lane == 0) rs[m] = rstd;
            GAS v2u* o8 = (GAS v2u*)(hb_out + (size_t)m * DM) + lane;
#pragma unroll
            for (int j = 0; j < 8; ++j) { const f32x4 y = v[j] * rstd; v2u w; w.x = pk2(y.x, y.y); w.y = pk2(y.z, y.w); o8[64 * j] = w; }
        }
    }
}

namespace att {
constexpr int KROWB = 272, VROWB = 320, KT = 32 * KROWB, VT = 32 * VROWB, STG = KT + VT, RPB_OFF = 2 * STG, QUADB = RPB_OFF + 2048;
static_assert(2 * QUADB <= RING_BYTES, "attention LDS");
constexpr float LOG2E = 1.4426950408889634f;
constexpr float C1 = 0.08838834764831845f * LOG2E;
__device__ __forceinline__ int crow(int r, int hi) { return (r & 3) + 8 * (r >> 2) + 4 * hi; }
typedef float f32x2_t __attribute__((ext_vector_type(2))); typedef __bf16 bf16x2_t __attribute__((ext_vector_type(2)));
__device__ __forceinline__ unsigned cvtpk(float lo, float hi) { f32x2_t v = {lo, hi}; bf16x2_t b = __builtin_convertvector(v, bf16x2_t); return __builtin_bit_cast(unsigned, b); }
__device__ __forceinline__ v4i16_t vtr(const LAS unsigned char* p) { return __builtin_amdgcn_ds_read_tr16_b64_v4i16((LAS v4i16_t*)p); }

template <int MODE>
__device__ __forceinline__ void attn_pair(LAS unsigned char* lds, const bf16* QKV, bf16* Y, const float* aux, int pu, int tid) {
    const int lane = tid & 63, wave = __builtin_amdgcn_readfirstlane(tid >> 6), quad = wave >> 2, wq = wave & 3, l32 = lane & 31, hi = lane >> 5, tq = tid & 255;
    LAS unsigned char* Ql = lds + quad * QUADB; LAS float* rpbl = (LAS float*)(Ql + RPB_OFF);
    const int hp = pu & 3, blk = (pu >> 2) & 31, b = pu >> 7, h = 2 * hp + quad;
    int qcol, kcol, vcol, ycol, qtok, t0 = 0, t1;
    int qloc = 0; float slope2 = 0.f;
    int kr0 = 0, kc0 = 0, lo_r = 0, lo_c = 0, RC = 0;
    float m_run, l_run;
    if (MODE == 0) {
        const int kvh = h >> 2; qcol = h * 128; kcol = 1024 + kvh * 128; vcol = 1280 + kvh * 128; ycol = h * 128;
        qloc = 32 * wq + l32; qtok = b * SEQ + blk * 128 + qloc;
        t0 = (blk == 0) ? 4 : 0; t1 = (blk == 31) ? 8 : 12;
        slope2 = __builtin_amdgcn_exp2f(-(float)(h + 1)) * LOG2E;
        m_run = aux[h] * LOG2E; l_run = (hi == 0) ? 1.f : 0.f;
    } else {
        const int bi = blk >> 2, bj = blk & 3;
        qcol = 1536 + h * 128; kcol = 2560 + h * 128; vcol = 3584 + h * 128; ycol = 1024 + h * 128;
        const int qrow = 8 * bi + 2 * wq + (l32 >> 4), qc = 16 * bj + (l32 & 15); qtok = b * SEQ + qrow * 64 + qc;
        kr0 = min(max(8 * bi - 4, 0), 49); kc0 = min(max(16 * bj - 8, 0), 33);
        lo_r = min(max(qrow - 4, 0), 56) - kr0; lo_c = min(max(qc - 8, 0), 48) - kc0;
        RC = (kr0 - qrow + 7) * 31 + (kc0 - qc + 15);
        t1 = 15;
        m_run = -1e30f; l_run = 0.f;
    }
    __syncthreads();
    if (MODE == 1) { for (int idx = tq; idx < 465; idx += 256) rpbl[idx] = aux[h * 465 + idx] * LOG2E; }
    bf16x8 qf[8];
    { const bf16* qp = QKV + (size_t)qtok * NIN + qcol + 8 * hi;
#pragma unroll
      for (int ds = 0; ds < 8; ++ds) qf[ds] = *(const bf16x8*)(qp + 16 * ds); }
    f32x16 o[4];
#pragma unroll
    for (int d = 0; d < 4; ++d)
#pragma unroll
        for (int r = 0; r < 16; ++r) o[d][r] = 0.f;
    const int ch = tq & 15, klb = tq >> 4;
    v4u kreg[2], vreg[2];
#define ATT_LOAD(tt) do { _Pragma("unroll") for (int i = 0; i < 2; ++i) { const int kl = klb + 16 * i; int tok; \
        if (MODE == 0) { const int pos = blk * 128 - 128 + 32 * (tt) + kl; tok = b * SEQ + min(max(pos, 0), SEQ - 1); } \
        else { tok = b * SEQ + (kr0 + (tt)) * 64 + kc0 + min(kl, 30); } \
        const bf16* rp = QKV + (size_t)tok * NIN + ch * 8; kreg[i] = *(const v4u*)(rp + kcol); vreg[i] = *(const v4u*)(rp + vcol); } } while (0)
#define ATT_WRITE(stg) do { _Pragma("unroll") for (int i = 0; i < 2; ++i) { const int kl = klb + 16 * i; \
        *(LAS v4u*)(Ql + (stg) * STG + kl * KROWB + ch * 16) = kreg[i]; *(LAS v4u*)(Ql + (stg) * STG + KT + kl * VROWB + ch * 16) = vreg[i]; } } while (0)
    ATT_LOAD(t0);
    ATT_WRITE(0);
    __syncthreads();
    const int koff = l32 * KROWB + hi * 16;
    const int voff = KT + (4 * hi + ((lane >> 2) & 3)) * VROWB + (16 * ((lane >> 4) & 1) + 4 * (lane & 3)) * 2;
    int cur = 0;
    for (int tt = t0; tt < t1; ++tt) {
        const bool more = tt + 1 < t1;
        if (more) ATT_LOAD(tt + 1);
        const LAS unsigned char* kaddr = Ql + cur * STG + koff;
        const LAS unsigned char* vaddr = Ql + cur * STG + voff;
        bool need_lane;
        if (MODE == 0) need_lane = (32 * tt + 31 >= qloc) && (32 * tt <= qloc + 256); else need_lane = (unsigned)(tt - lo_r) < 8u;
        if (__builtin_amdgcn_ballot_w64(need_lane) != 0ull) {
        f32x16 p0;
#pragma unroll
        for (int r = 0; r < 16; ++r) p0[r] = 0.f;
#pragma unroll
        for (int ds = 0; ds < 8; ++ds) {
            const bf16x8 k0 = *(const LAS bf16x8*)(kaddr + ds * 32);
            p0 = __builtin_amdgcn_mfma_f32_32x32x16_bf16(k0, qf[ds], p0, 0, 0, 0);
        }
        const float NEG = -INFINITY;
        float mx = NEG;
#pragma unroll
        for (int r = 0; r < 16; ++r) {
            const int kl = crow(r, hi);
            if (MODE == 0) {
                const int kk0 = 32 * tt + kl;
                const int d0 = qloc + 128 - kk0;
                const int a0 = d0 < 0 ? -d0 : d0;
                const int pos0 = blk * 128 - 128 + kk0;
                const bool v0 = (a0 <= 128) && ((unsigned)pos0 < (unsigned)SEQ);
                p0[r] = v0 ? (p0[r] * C1 - slope2 * (float)a0) : NEG;
            } else {
                const bool v0 = ((unsigned)(kl - lo_c) < 16u) && ((unsigned)(tt - lo_r) < 8u);
                const int i0 = tt * 31 + kl + RC;
                const float b0 = rpbl[v0 ? i0 : 0];
                p0[r] = v0 ? (p0[r] * C1 + b0) : NEG;
            }
            mx = fmaxf(mx, p0[r]);
        }
        mx = fmaxf(mx, __shfl_xor(mx, 32));
        const float m_new = fmaxf(m_run, mx);
        const float alpha = __builtin_amdgcn_exp2f(m_run - m_new);
        m_run = m_new;
        float ps = 0.f;
#pragma unroll
        for (int r = 0; r < 16; ++r) { p0[r] = __builtin_amdgcn_exp2f(p0[r] - m_new); ps += p0[r]; }
        l_run = l_run * alpha + ps;
#pragma unroll
        for (int d = 0; d < 4; ++d)
#pragma unroll
            for (int r = 0; r < 16; ++r) o[d][r] *= alpha;
        bf16x8 pf[2];
#pragma unroll
        for (int i = 0; i < 2; ++i) {
            v4u w0;
            w0.x = cvtpk(p0[8 * i + 0], p0[8 * i + 1]); w0.y = cvtpk(p0[8 * i + 2], p0[8 * i + 3]); w0.z = cvtpk(p0[8 * i + 4], p0[8 * i + 5]); w0.w = cvtpk(p0[8 * i + 6], p0[8 * i + 7]);
            pf[i] = __builtin_bit_cast(bf16x8, w0);
        }
#pragma unroll
        for (int d = 0; d < 4; ++d)
#pragma unroll
            for (int i = 0; i < 2; ++i) {
                const LAS unsigned char* vp = vaddr + (16 * i) * VROWB + 64 * d;
                const v4i16_t lo = vtr(vp), hh = vtr(vp + 8 * VROWB);
                const bf16x8 vf = (bf16x8){lo[0], lo[1], lo[2], lo[3], hh[0], hh[1], hh[2], hh[3]};
                o[d] = __builtin_amdgcn_mfma_f32_32x32x16_bf16(vf, pf[i], o[d], 0, 0, 0);
            }
        }
        if (more) ATT_WRITE(cur ^ 1);
        __syncthreads();
        cur ^= 1;
    }
#undef ATT_LOAD
#undef ATT_WRITE
    l_run += __shfl_xor(l_run, 32);
    const float inv = 1.0f / l_run;
    bf16* yq = Y + (size_t)qtok * DM + ycol + 8 * hi;
#pragma unroll
    for (int d = 0; d < 4; ++d)
#pragma unroll
        for (int ap = 0; ap < 2; ++ap) { const int a = 2 * ap;
            const unsigned ax = cvtpk(o[d][4 * a] * inv, o[d][4 * a + 1] * inv), ay = cvtpk(o[d][4 * a + 2] * inv, o[d][4 * a + 3] * inv);
            const unsigned bx_ = cvtpk(o[d][4 * a + 4] * inv, o[d][4 * a + 5] * inv), by_ = cvtpk(o[d][4 * a + 6] * inv, o[d][4 * a + 7] * inv);
            const auto rx = __builtin_amdgcn_permlane32_swap(ax, bx_, false, false), ry = __builtin_amdgcn_permlane32_swap(ay, by_, false, false);
            v4u w; w.x = rx[0]; w.y = ry[0]; w.z = rx[1]; w.w = ry[1];
            *(v4u*)(yq + 32 * d + 16 * ap) = w; }
}
}

typedef GAS unsigned gu32;
#define RLX_AGENT __ATOMIC_RELAXED, __HIP_MEMORY_SCOPE_AGENT
#define XB_TMO      128
#define XB_XCNT(j)  (256  + 64 * (j))
#define XB_XSUB(j)  (1280 + 64 * (j))
#define XB_XGEN(j)  (2304 + 64 * (j))
#define XB_TOP      3328
#define XB_TOPGEN   3392
#define XCD_BAR_WORDS 3456
#define XB_SPIN_CAP (1u << 18)

__device__ __forceinline__ unsigned xb_ld(unsigned* p)              { return __hip_atomic_load(p, __ATOMIC_RELAXED, __HIP_MEMORY_SCOPE_AGENT); }
__device__ __forceinline__ unsigned xb_add(unsigned* p, unsigned v) { return __hip_atomic_fetch_add(p, v, __ATOMIC_RELAXED, __HIP_MEMORY_SCOPE_AGENT); }
__device__ __forceinline__ unsigned xb_xcc_id() { return (unsigned)__builtin_amdgcn_s_getreg((3 << 11) | 20) & 0xFu; }
#define XB_SPIN(cond, bar) do { unsigned _sp = 0; while (cond) { __builtin_amdgcn_s_sleep(1); \
    if ((++_sp & 255u) == 0u) { if (xb_ld(&(bar)[XB_TMO])) break; if (_sp > XB_SPIN_CAP) { atomicAdd(&(bar)[XB_TMO], 1u); break; } } } } while (0)

struct XcdBarrier {
    unsigned* bar; unsigned x;
    volatile LAS unsigned* st;
};

__device__ __forceinline__ XcdBarrier xcd_barrier_post(unsigned* bar, volatile LAS unsigned* st) {
    XcdBarrier b; b.bar = bar; b.x = xb_xcc_id(); b.st = st;
    if (threadIdx.x == 0) (void)xb_add(&bar[XB_XCNT(b.x)], 1u);
    return b;
}
__device__ __forceinline__ void xcd_barrier_complete(unsigned* bar, unsigned x, unsigned& nloc, unsigned& nx) {
    const unsigned G = gridDim.x * gridDim.y * gridDim.z;
    unsigned sum, cnt, mine, sp = 0u;
    for (;;) {
        sum = 0u; cnt = 0u; mine = 0u;
#pragma unroll
        for (unsigned j = 0; j < 16; ++j) { const unsigned c = xb_ld(&bar[XB_XCNT(j)]); sum += c; cnt += (c > 0u) ? 1u : 0u; mine = (j == x) ? c : mine; }
        if (sum == G) break;
        __builtin_amdgcn_s_sleep(1);
        if ((++sp & 255u) == 0u) { if (xb_ld(&bar[XB_TMO])) break; if (sp > XB_SPIN_CAP) { atomicAdd(&bar[XB_TMO], 1u); break; } }
    }
    nloc = mine > 0u ? mine : 1u; nx = cnt > 0u ? cnt : 1u;
}

__device__ __forceinline__ void xcd_barrier(const XcdBarrier& b) {
    asm volatile("s_waitcnt vmcnt(0)" ::: "memory");
    __syncthreads();
    if (threadIdx.x == 0) {
        unsigned* bar = b.bar;
        __builtin_amdgcn_s_waitcnt(0);
        unsigned nloc = b.st[0], nx = b.st[1];
        if (nloc == 0u) { xcd_barrier_complete(bar, b.x, nloc, nx); b.st[0] = nloc; b.st[1] = nx; }
        const unsigned old = xb_add(&bar[XB_XSUB(b.x)], 1u);
        const unsigned gen = old / nloc;
        if (old + 1u == (gen + 1u) * nloc) {
            __builtin_amdgcn_fence(__ATOMIC_RELEASE, "agent");
            asm volatile("s_waitcnt vmcnt(0)" ::: "memory");
            const unsigned og = xb_add(&bar[XB_TOP], 1u);
            const unsigned tg = og / nx;
            if (og + 1u == (tg + 1u) * nx) xb_add(&bar[XB_TOPGEN], 1u);
            else XB_SPIN(xb_ld(&bar[XB_TOPGEN]) == tg, bar);
            __builtin_amdgcn_fence(__ATOMIC_ACQUIRE, "agent");
            xb_add(&bar[XB_XGEN(b.x)], 1u);
            asm volatile("s_waitcnt vmcnt(0)" ::: "memory");
        } else {
            XB_SPIN(xb_ld(&bar[XB_XGEN(b.x)]) == gen, bar);
            __builtin_amdgcn_fence(__ATOMIC_ACQUIRE, "agent");
            asm volatile("s_waitcnt vmcnt(0)" ::: "memory");
        }
    }
    __syncthreads();
}

struct Args { const float* in[18]; float* out; unsigned char* ws; int ph_lo, ph_hi; };
__global__ void __launch_bounds__(NWAVES * 64, 2) mk_fwd(Args args) {
    extern __shared__ __attribute__((aligned(16))) unsigned char lds_raw[];
    LAS unsigned char* lds = (LAS unsigned char*)lds_raw;
    const int tid = threadIdx.x, lane = tid & 63, wave = __builtin_amdgcn_readfirstlane(tid >> 6);
    const int G = gridDim.x, bx = blockIdx.x;
    const int gw = bx * NWAVES + wave, NGW = G * NWAVES;
    unsigned char* ws = args.ws;
    const float* x = args.in[0];
    float* out = args.out;
    float* RS = (float*)(ws + WS_RS); bf16* WMIX = (bf16*)((unsigned char*)out + 66 * MiB);     bf16* W2 = (bf16*)out;
    bf16* WREG = (bf16*)(ws + WS_W); bf16* XN = (bf16*)(ws + WS_XN); bf16* FB = (bf16*)(ws + WS_F); bf16* R1 = (bf16*)(ws + WS_R1);
    LAS float* scr = (LAS float*)(lds + wave * 16384);
    unsigned* qctr = (unsigned*)(ws + WS_BAR + 14336);
    volatile LAS unsigned* qslot = (volatile LAS unsigned*)(lds + RING_BYTES + 96);
    const int lm0 = (G == 256) ? 2048 * (bx & 7) + 8 * (bx >> 3) + wave : gw, lmstride = (G == 256) ? 256 : NGW, lmend = (G == 256) ? 2048 * (bx & 7) + 2048 : M;
    const int lo = args.ph_lo, hi = args.ph_hi;
    volatile LAS unsigned* xst = (volatile LAS unsigned*)(lds + RING_BYTES + 64);
    if (tid < 2) xst[tid] = 0u;
    __syncthreads();
    if (args.ph_lo < 0) cg::this_grid().sync();
    XcdBarrier xbar; xbar.bar = (unsigned*)(ws + WS_BAR); xbar.x = 0; xbar.st = xst;
#if !MK_MULTI
    xbar = xcd_barrier_post((unsigned*)(ws + WS_BAR), xst);
#endif
#ifndef PHASE_MASK
#define PHASE_MASK 0xFFF
#endif
#define IN(k) (((PHASE_MASK >> (k)) & 1) && lo <= (k) && (k) < hi)
#ifndef PROBE_REP_MASK
#define PROBE_REP_MASK 0
#endif
#ifndef PROBE_SYNC_REP
#define PROBE_SYNC_REP 1
#endif
#define NREP(k) (1 + ((PROBE_REP_MASK >> (k)) & 1))
#define REP(k) for (int rep_ = 0; rep_ < 1 + ((PROBE_REP_MASK >> (k)) & 1); ++rep_)
#if MK_MULTI
#define SEAM(k) do { } while (0)
#else
#define SEAM(k) do { if (IN(k) && IN((k) + 1)) { for (int sr_ = 0; sr_ < PROBE_SYNC_REP; ++sr_) { xcd_barrier(xbar); } } } while (0)
#endif
    if (IN(0)) REP(0) {
        { TrMat t{args.in[2], DM, 2 * DFF, (bf16*)((unsigned char*)WREG + W_FFN_IN), DM, 0, true, args.in[1]}; tr_run(t, scr, gw, NGW, lane); }
        norm_rows(lm0, lmstride, lmend, lane, x, nullptr, nullptr, nullptr, 0.f, XN, RS, nullptr);
        __syncthreads();
    }
    SEAM(0);
    if (IN(1)) {
        pg8::Gemm g{XN, (const bf16*)((unsigned char*)WREG + W_FFN_IN), M, 2 * DFF, DM}; pg8::StaticOrder S; S.init(M, 2 * DFF, G, bx, NREP(1));
        pg8::EpiSwiGLU E{R1, DFF};
        pg8::gemm_phase<pg8::EpiSwiGLU, pg8::StaticOrder, PG8_ALIGN, PG8_SP2>(lds, g, S, E);
        { TrMat t{args.in[3], DFF, DM, (bf16*)((unsigned char*)WREG + W_FFN_OUT), DFF, 0, false, nullptr}; tr_run_dyn(t, scr, qctr + 0, qslot, wave, lane, tid, 0, 1, 1); }
        { TrMat t{args.in[6], DM, NIN, (bf16*)((unsigned char*)WMIX + W_MIX_IN), DM, 0, false, args.in[5]}; tr_run_dyn(t, scr, qctr + 16, qslot, wave, lane, tid, 0, 4, 1); }
        __syncthreads();
    }
    SEAM(1);
    if (IN(2)) {
        pg8::Gemm g{R1, (const bf16*)((unsigned char*)WREG + W_FFN_OUT), M, DM, DFF}; pg8::StaticOrder S; S.init(M, DM, G, bx, NREP(2));
        pg8::EpiStore E{FB, DM};
        pg8::gemm_phase<pg8::EpiStore, pg8::StaticOrder, PG8_ALIGN, PG8_SP2>(lds, g, S, E);
        { TrMat t{args.in[6], DM, NIN, (bf16*)((unsigned char*)WMIX + W_MIX_IN), DM, 0, false, args.in[5]};
          tr_run_dyn(t, scr, qctr + 32, qslot, wave, lane, tid, 1, 4, 3); }
        if (G != 256) {
            { TrMat t{args.in[10], 1024, DM, (bf16*)((unsigned char*)WMIX + W_MIX_UP), DM, 0, false, nullptr}; tr_run(t, scr, gw, NGW, lane); }
            { TrMat t{args.in[11], 1024, DM, (bf16*)((unsigned char*)WMIX + W_MIX_UP), DM, 1024, false, nullptr}; tr_run(t, scr, gw, NGW, lane); }
            { TrMat t{args.in[12], DM, DM, (bf16*)((unsigned char*)WMIX + W_MIX_OUT), DM, 0, false, nullptr}; tr_run(t, scr, gw, NGW, lane); }
        }
        __syncthreads();
    }
    SEAM(2);
    if (IN(3)) REP(3) {
        norm_rows(lm0, lmstride, lmend, lane, nullptr, XN, FB, args.in[4], 0.5f, XN, RS, nullptr);
        __syncthreads();
    }
    SEAM(3);
    if (IN(4)) {
        pg8::Gemm g{XN, (const bf16*)((unsigned char*)WMIX + W_MIX_IN), M, NIN, DM}; pg8::StaticOrder S; S.init(M, NIN, G, bx, NREP(4));
        pg8::EpiInProj E{R1, NIN, args.in[7], GATE_COL / 256};
        pg8::gemm_phase<pg8::EpiInProj, pg8::StaticOrder, PG8_ALIGN, PG8_SP2>(lds, g, S, E);
        if (G == 256 && bx >= 128) {
            const int gw2 = (bx - 128) * NWAVES + wave, NGW2 = 128 * NWAVES;
            { TrMat t{args.in[10], 1024, DM, (bf16*)((unsigned char*)WMIX + W_MIX_UP), DM, 0, false, nullptr}; tr_run(t, scr, gw2, NGW2, lane); }
            { TrMat t{args.in[11], 1024, DM, (bf16*)((unsigned char*)WMIX + W_MIX_UP), DM, 1024, false, nullptr}; tr_run(t, scr, gw2, NGW2, lane); }
            { TrMat t{args.in[12], DM, DM, (bf16*)((unsigned char*)WMIX + W_MIX_OUT), DM, 0, false, nullptr}; tr_run(t, scr, gw2, NGW2, lane); }
            { TrMat t{args.in[15], DM, 2 * DFF, (bf16*)((unsigned char*)W2 + W_FFN_IN), DM, 0, true, args.in[14]}; tr_run(t, scr, gw2, NGW2, lane); }
            __syncthreads();
        }
    }
    SEAM(4);
    if (IN(5)) {
        if (G == 256) {
            for (int k = 0; k < 4 * NREP(5); ++k) { const int pu = 64 * (bx & 7) + (bx >> 3) + 32 * (k & 1);
                if (((k >> 1) & 1) == 0) att::attn_pair<0>(lds, R1, FB, args.in[8], pu, tid);
                else att::attn_pair<1>(lds, R1, FB, args.in[9], pu, tid);
            }
        } else {
            for (int uu = bx; uu < 1024 * NREP(5); uu += G) { const int u = uu & 1023;
                if (u < 512) att::attn_pair<0>(lds, R1, FB, args.in[8], u, tid);
                else att::attn_pair<1>(lds, R1, FB, args.in[9], u - 512, tid);
            }
        }
        __syncthreads();
        if (G == 256) { TrMat t{args.in[16], DFF, DM, (bf16*)((unsigned char*)W2 + W_FFN_OUT), DFF, 0, false, nullptr}; tr_run_dyn(t, scr, qctr + 48, qslot, wave, lane, tid, 0, 3, 1); }
    }
    SEAM(5);
    if (IN(6)) {
        pg8::Gemm g{FB, (const bf16*)((unsigned char*)WMIX + W_MIX_UP), M, DM, DM}; pg8::StaticOrder S; S.init(M, DM, G, bx, NREP(6));
        pg8::EpiUp E{R1, NIN, R1, NIN, GATE_COL, GATE_COL + DM, 16};
        pg8::gemm_phase<pg8::EpiUp, pg8::StaticOrder, PG8_ALIGN, PG8_SP2>(lds, g, S, E);
        if (G == 256) { TrMat t{args.in[16], DFF, DM, (bf16*)((unsigned char*)W2 + W_FFN_OUT), DFF, 0, false, nullptr}; tr_run_dyn(t, scr, qctr + 64, qslot, wave, lane, tid, 1, 3, 1); }
    }
    SEAM(6);
    if (IN(7)) {
        pg8::Gemm g{R1, (const bf16*)((unsigned char*)WMIX + W_MIX_OUT), M, DM, DM, NIN}; pg8::StaticOrder S; S.init(M, DM, G, bx, NREP(7));
        pg8::EpiStore E{FB, DM};
        pg8::gemm_phase<pg8::EpiStore, pg8::StaticOrder, PG8_ALIGN, PG8_SP2>(lds, g, S, E);
        if (G == 256) { TrMat t{args.in[16], DFF, DM, (bf16*)((unsigned char*)W2 + W_FFN_OUT), DFF, 0, false, nullptr}; tr_run_dyn(t, scr, qctr + 80, qslot, wave, lane, tid, 2, 3, 1); }
    }
    SEAM(7);
    if (IN(8)) REP(8) {
        norm_rows(lm0, lmstride, lmend, lane, nullptr, XN, FB, args.in[13], 1.0f, XN, RS, nullptr);
        if (G != 256) {
            { TrMat t{args.in[15], DM, 2 * DFF, (bf16*)((unsigned char*)W2 + W_FFN_IN), DM, 0, true, args.in[14]}; tr_run(t, scr, gw, NGW, lane); }
            { TrMat t{args.in[16], DFF, DM, (bf16*)((unsigned char*)W2 + W_FFN_OUT), DFF, 0, false, nullptr}; tr_run(t, scr, gw, NGW, lane); }
        }
        __syncthreads();
    }
    SEAM(8);
    if (IN(9)) {
        pg8::Gemm g{XN, (const bf16*)((unsigned char*)W2 + W_FFN_IN), M, 2 * DFF, DM}; pg8::StaticOrder S; S.init(M, 2 * DFF, G, bx, NREP(9));
        pg8::EpiSwiGLU E{R1, DFF};
        pg8::gemm_phase<pg8::EpiSwiGLU, pg8::StaticOrder, PG8_ALIGN, PG8_SP2>(lds, g, S, E);
    }
    SEAM(9);
    if (IN(10)) {
        pg8::Gemm g{R1, (const bf16*)((unsigned char*)W2 + W_FFN_OUT), M, DM, DFF}; pg8::StaticOrder S; S.init(M, DM, G, bx, NREP(10));
        pg8::EpiStore E{FB, DM};
        pg8::gemm_phase<pg8::EpiStore, pg8::StaticOrder, PG8_ALIGN, PG8_SP2>(lds, g, S, E);
    }
    SEAM(10);
    if (IN(11)) REP(11) {
        norm_rows(lm0, lmstride, lmend, lane, nullptr, XN, FB, args.in[17], 0.5f, nullptr, RS, out);
    }
#undef IN
#undef SEAM
}

extern "C" void kernel_launch(void* const* d_in, const int* in_sizes, int n_in, void* d_out, int out_size, void* d_ws, size_t ws_size, hipStream_t stream) {
    static int grid = 0;
    if (grid == 0) {
        if (n_in != 18 || in_sizes[0] != M * DM || out_size != M * DM || ws_size < WS_END) { fprintf(stderr, "kernel_launch: unexpected shapes (n_in %d, in0 %d, out %d, ws %zu)\n", n_in, n_in > 0 ? in_sizes[0] : -1, out_size, ws_size); grid = -1; return; }
        int dev = 0, cus = 0, per_cu = 0;
        if (hipGetDevice(&dev) != hipSuccess || hipDeviceGetAttribute(&cus, hipDeviceAttributeMultiprocessorCount, dev) != hipSuccess) { grid = -1; return; }
        if (hipFuncSetAttribute((const void*)mk_fwd, hipFuncAttributeMaxDynamicSharedMemorySize, LDS_BYTES) != hipSuccess) { fprintf(stderr, "kernel_launch: hipFuncSetAttribute failed\n"); grid = -1; return; }
        if (hipOccupancyMaxActiveBlocksPerMultiprocessor(&per_cu, (const void*)mk_fwd, NWAVES * 64, LDS_BYTES) != hipSuccess || per_cu < 1) { fprintf(stderr, "kernel_launch: occupancy query says %d\n", per_cu); per_cu = 1; }
        (void)hipGetLastError();
        grid = cus;
    }
    if (grid < 0) return;
    Args a{};
    for (int i = 0; i < 18; ++i) a.in[i] = (const float*)d_in[i];
    a.out = (float*)d_out; a.ws = (unsigned char*)d_ws;
#if MK_MULTI
    for (int p = 0; p < N_PHASES; ++p) { a.ph_lo = p; a.ph_hi = p + 1; hipLaunchKernelGGL(mk_fwd, dim3(grid), dim3(NWAVES * 64), LDS_BYTES, stream, a); }
#else
    a.ph_lo = 0; a.ph_hi = N_PHASES;
    if (hipMemsetAsync((char*)d_ws + WS_BAR, 0, WS_BAR_BYTES, stream) != hipSuccess) { fprintf(stderr, "kernel_launch: memset of the barrier words failed\n"); return; }
    void* kargs[] = {&a};
    hipError_t e = hipLaunchCooperativeKernel((const void*)mk_fwd, dim3(grid), dim3(NWAVES * 64), kargs, LDS_BYTES, stream);
    if (e != hipSuccess) fprintf(stderr, "kernel_launch: cooperative launch failed: %s (grid %d)\n", hipGetErrorString(e), grid);
#endif
}
```

```cpp
#include <hip/hip_runtime.h>
#include <hip/hip_cooperative_groups.h>
#include <cstdio>
#include <cstdint>
#include <cmath>
namespace cg = cooperative_groups;
namespace pg8 {
#define PG8_LAS __attribute__((address_space(3)))
typedef unsigned short bf16_t;
typedef short bf16x8 __attribute__((ext_vector_type(8)));
typedef float f32x4 __attribute__((ext_vector_type(4)));
typedef unsigned u32x4 __attribute__((ext_vector_type(4)));
constexpr int BM = 256, BK = 64, HALF = 128, HTB = HALF * BK * 2  , STAGE_BYTES = 8 * HTB, NXCD = 8, WGM = 8;

__host__ __device__ __forceinline__ int lds_byte(int r, int c) { const int st = (r >> 4) * 2 + (c >> 5), rr = r & 15, cc = c & 31, ob = rr * 64 + cc * 2; return st * 1024 + (ob ^ (((ob >> 9) & 1) << 5)); }
__host__ __device__ __forceinline__ void stage_rc(int b, int& R, int& C) { const int st = b / 1024, sb = b % 1024, swz = sb ^ (((sb >> 9) & 1) << 5); R = (st >> 1) * 16 + swz / 64; C = (st & 1) * 32 + (swz % 64) / 2; }
__host__ __device__ __forceinline__ int perm32(int rho) { const int n = rho >> 4, i = rho & 15; return 8 * (i >> 2) + 4 * n + (i & 3); }

struct Unit { int pm, pn; };
struct Gemm { const bf16_t* A; const bf16_t* Bt; int M, N, K, lda; };

struct StaticOrder {
    int nM, nN, nwg, G, c, rep;
    __host__ __device__ void init(int M, int N, int G_, int c_, int rep_ = 1) { nM = M / BM; nN = N / BM; nwg = nM * nN; G = G_; c = c_; rep = rep_; }
    __host__ __device__ bool next(int i, Unit& u) const {
        long L = (long)i * G + c; if (L >= (long)nwg * rep) return false; L %= nwg;
        int wgid = (int)L; { const int q = nwg / NXCD, r = nwg % NXCD, xcd = wgid % NXCD, off = wgid / NXCD; wgid = (xcd < r ? xcd * (q + 1) : r * (q + 1) + (xcd - r) * q) + off; }
        const int nig = WGM * nN, gid = wgid / nig, fm = gid * WGM, gsz = (nM - fm) < WGM ? (nM - fm) : WGM;
        u.pm = fm + ((wgid % nig) % gsz); u.pn = (wgid % nig) / gsz; return true;
    }
    __device__ __forceinline__ void a_ready(const Unit&) const {}
    __device__ __forceinline__ void done(const Unit&) const {}
};

__device__ __forceinline__ unsigned cvt_pk_bf16(float lo, float hi) { unsigned r; asm volatile("v_cvt_pk_bf16_f32 %0, %1, %2" : "=v"(r) : "v"(lo), "v"(hi)); return r; }
typedef float f32x2 __attribute__((ext_vector_type(2)));
__device__ __forceinline__ float bflo(unsigned u) { return __uint_as_float(u << 16); }
__device__ __forceinline__ float bfhi(unsigned u) { return __uint_as_float(u & 0xffff0000u); }
__device__ __forceinline__ float sigmoid_f(float x) { return __builtin_amdgcn_rcpf(1.0f + __builtin_amdgcn_exp2f(-1.4426950408889634f * x)); }

struct EpiStore {
    static constexpr bool PERM = true, AFTER_DRAIN = false, MID = false; static constexpr int NSTORE = 16;
    bf16_t* O; int ldc;
    __device__ __forceinline__ void operator()(const f32x4 (&acc)[2][2][4][2], const Unit& u, int wr, int wc, int fr, int fq) const {
        const int row0 = u.pm * BM + wr * 64 + fr, col0 = u.pn * BM + wc * 32 + 8 * fq;
#pragma unroll
        for (int ai = 0; ai < 2; ++ai)
#pragma unroll
            for (int m = 0; m < 4; ++m) { bf16_t* rowp = O + (size_t)(row0 + ai * HALF + m * 16) * ldc + col0;
#pragma unroll
                for (int bj = 0; bj < 2; ++bj) { const f32x4 v0 = acc[ai][bj][m][0], v1 = acc[ai][bj][m][1];
                    u32x4 w; w.x = cvt_pk_bf16(v0[0], v0[1]); w.y = cvt_pk_bf16(v0[2], v0[3]); w.z = cvt_pk_bf16(v1[0], v1[1]); w.w = cvt_pk_bf16(v1[2], v1[3]);
                    *(u32x4*)(rowp + bj * HALF) = w; } }
    }
};

struct EpiSwiGLU {
    static constexpr bool PERM = true, AFTER_DRAIN = false, MID = false; static constexpr int NSTORE = 8;
    bf16_t* O; int ldc;
    __device__ __forceinline__ void operator()(const f32x4 (&acc)[2][2][4][2], const Unit& u, int wr, int wc, int fr, int fq) const {
        const int row0 = u.pm * BM + wr * 64 + fr, col0 = u.pn * HALF + wc * 32 + 8 * fq;
#pragma unroll
        for (int ai = 0; ai < 2; ++ai)
#pragma unroll
            for (int m = 0; m < 4; ++m) { bf16_t* rowp = O + (size_t)(row0 + ai * HALF + m * 16) * ldc + col0;
                float r[8];
#pragma unroll
                for (int n = 0; n < 2; ++n)
#pragma unroll
                    for (int j = 0; j < 4; j += 2) {
                        const f32x2 g = (f32x2){acc[ai][0][m][n][j], acc[ai][0][m][n][j + 1]}, uu = (f32x2){acc[ai][1][m][n][j], acc[ai][1][m][n][j + 1]};
                        const f32x2 t = g * (-1.4426950408889634f); f32x2 e; e.x = __builtin_amdgcn_exp2f(t.x); e.y = __builtin_amdgcn_exp2f(t.y);
                        const f32x2 d = e + 1.0f; f32x2 q; q.x = __builtin_amdgcn_rcpf(d.x); q.y = __builtin_amdgcn_rcpf(d.y);
                        const f32x2 o = (g * uu) * q; r[4 * n + j] = o.x; r[4 * n + j + 1] = o.y; }
                u32x4 w; w.x = cvt_pk_bf16(r[0], r[1]); w.y = cvt_pk_bf16(r[2], r[3]); w.z = cvt_pk_bf16(r[4], r[5]); w.w = cvt_pk_bf16(r[6], r[7]);
                *(u32x4*)rowp = w; }
    }
};

struct EpiInProj {
    static constexpr bool PERM = true, AFTER_DRAIN = false, MID = false; static constexpr int NSTORE = 16;
    bf16_t* O; int ldc; const float* bias; int gate_tile0;
    __device__ __forceinline__ void operator()(const f32x4 (&acc)[2][2][4][2], const Unit& u, int wr, int wc, int fr, int fq) const {
        const int row0 = u.pm * BM + wr * 64 + fr, col0 = u.pn * BM + wc * 32 + 8 * fq;
        const bool gate = u.pn >= gate_tile0;
        f32x4 bv[2][2];
#pragma unroll
        for (int bj = 0; bj < 2; ++bj)
#pragma unroll
            for (int n = 0; n < 2; ++n) bv[bj][n] = gate ? *(const f32x4*)(bias + (col0 - gate_tile0 * BM) + bj * HALF + 4 * n) : (f32x4){0.f, 0.f, 0.f, 0.f};
#pragma unroll
        for (int ai = 0; ai < 2; ++ai)
#pragma unroll
            for (int m = 0; m < 4; ++m) { bf16_t* rowp = O + (size_t)(row0 + ai * HALF + m * 16) * ldc + col0;
#pragma unroll
                for (int bj = 0; bj < 2; ++bj) { f32x4 v0 = acc[ai][bj][m][0], v1 = acc[ai][bj][m][1];
                    if (gate) {
                        const f32x4 t0 = (v0 + bv[bj][0]) * (-1.4426950408889634f), t1 = (v1 + bv[bj][1]) * (-1.4426950408889634f);
                        f32x4 e0, e1;
#pragma unroll
                        for (int j = 0; j < 4; ++j) { e0[j] = __builtin_amdgcn_exp2f(t0[j]); e1[j] = __builtin_amdgcn_exp2f(t1[j]); }
                        e0 = e0 + 1.0f; e1 = e1 + 1.0f;
#pragma unroll
                        for (int j = 0; j < 4; ++j) { v0[j] = __builtin_fmaxf(__builtin_amdgcn_rcpf(e0[j]), 9.5367431640625e-07f); v1[j] = __builtin_fmaxf(__builtin_amdgcn_rcpf(e1[j]), 9.5367431640625e-07f); } }
                    u32x4 w; w.x = cvt_pk_bf16(v0[0], v0[1]); w.y = cvt_pk_bf16(v0[2], v0[3]); w.z = cvt_pk_bf16(v1[0], v1[1]); w.w = cvt_pk_bf16(v1[2], v1[3]);
                    *(u32x4*)(rowp + bj * HALF) = w; } }
    }
};

struct EpiUp {
    static constexpr bool PERM = true, AFTER_DRAIN = false, MID = true; static constexpr int NSTORE = 16;
    bf16_t* O; int ldc; const bf16_t* G; int ldg, ga_col, gb_col, kmid;
    __device__ __forceinline__ void mid(f32x4 (&acc)[2][2][4][2], const Unit& u, int wr, int wc, int fr, int fq) const {
        const int row0 = u.pm * BM + wr * 64 + fr, col0 = u.pn * BM + wc * 32 + 8 * fq;
        unsigned off = (unsigned)row0 * (unsigned)ldg + (unsigned)col0; asm volatile("" : "+v"(off));
#pragma unroll
        for (int ai = 0; ai < 2; ++ai)
#pragma unroll
            for (int m = 0; m < 4; ++m) { const bf16_t* gp = G + (off + (unsigned)((ai * HALF + m * 16) * ldg));
#pragma unroll
                for (int bj = 0; bj < 2; ++bj) { const u32x4 a = *(const u32x4*)(gp + ga_col + bj * HALF), b = *(const u32x4*)(gp + gb_col + bj * HALF);
                    f32x4 r0, r1;
                    r0[0] = bflo(a.x) * __builtin_amdgcn_rcpf(bflo(b.x)); r0[1] = bfhi(a.x) * __builtin_amdgcn_rcpf(bfhi(b.x));
                    r0[2] = bflo(a.y) * __builtin_amdgcn_rcpf(bflo(b.y)); r0[3] = bfhi(a.y) * __builtin_amdgcn_rcpf(bfhi(b.y));
                    r1[0] = bflo(a.z) * __builtin_amdgcn_rcpf(bflo(b.z)); r1[1] = bfhi(a.z) * __builtin_amdgcn_rcpf(bfhi(b.z));
                    r1[2] = bflo(a.w) * __builtin_amdgcn_rcpf(bflo(b.w)); r1[3] = bfhi(a.w) * __builtin_amdgcn_rcpf(bfhi(b.w));
                    acc[ai][bj][m][0] *= r0; acc[ai][bj][m][1] *= r1; }
                asm volatile("" ::: "memory"); }
    }
    __device__ __forceinline__ void operator()(const f32x4 (&acc)[2][2][4][2], const Unit& u, int wr, int wc, int fr, int fq) const {
        const int row0 = u.pm * BM + wr * 64 + fr, col0 = u.pn * BM + wc * 32 + 8 * fq;
#pragma unroll
        for (int ai = 0; ai < 2; ++ai)
#pragma unroll
            for (int m = 0; m < 4; ++m) { const size_t row = (size_t)(row0 + ai * HALF + m * 16); const bf16_t* gp = G + row * ldg + col0 + gb_col; bf16_t* rowp = O + row * ldc + col0;
#pragma unroll
                for (int bj = 0; bj < 2; ++bj) { const u32x4 b = *(const u32x4*)(gp + bj * HALF); const f32x4 v0 = acc[ai][bj][m][0], v1 = acc[ai][bj][m][1];
                    u32x4 w; w.x = cvt_pk_bf16(v0[0] * bflo(b.x), v0[1] * bfhi(b.x)); w.y = cvt_pk_bf16(v0[2] * bflo(b.y), v0[3] * bfhi(b.y));
                    w.z = cvt_pk_bf16(v1[0] * bflo(b.z), v1[1] * bfhi(b.z)); w.w = cvt_pk_bf16(v1[2] * bflo(b.w), v1[3] * bfhi(b.w));
                    *(u32x4*)(rowp + bj * HALF) = w; }
                asm volatile("" ::: "memory"); }
    }
};

template <class Epi, class Sched, bool ALIGN_EPI = false, bool SP2 = false>
__device__ __forceinline__ void gemm_phase(PG8_LAS unsigned char* lds, const Gemm g, const Sched& S, const Epi& E) {
    const int tid = threadIdx.x, wid = __builtin_amdgcn_readfirstlane(tid >> 6), lane = tid & 63, wr = wid >> 2, wc = wid & 3, fr = lane & 15, fq = lane >> 4;
    const int K = g.K, nt = K / BK, lda = g.lda ? g.lda : K;
    unsigned voffA[2], voffB[2];
#pragma unroll
    for (int i = 0; i < 2; ++i) { int R, C; stage_rc(tid * 16 + i * 8192, R, C); const int Rb = Epi::PERM ? ((R & ~31) + perm32(R & 31)) : R;
        voffA[i] = (unsigned)(R * lda + C) * 2u; voffB[i] = (unsigned)(Rb * K + C) * 2u; }
    const size_t kstep = (size_t)(BK * 2);
    const size_t hstep = (size_t)HALF * K * 2;
    const size_t tstep = 2 * hstep;
    const size_t hstepA = (size_t)HALF * lda * 2, tstepA = 2 * hstepA;
    const unsigned ldsw = (unsigned)wid * 1024u;
    const int aoff = lds_byte(wr * 64 + fr, fq * 8), boff = lds_byte(wc * 32 + fr, fq * 8);
#define PG8_SA(b, h) (((b) * 2 + (h)) * HTB)
#define PG8_SB(b, h) ((4 + (b) * 2 + (h)) * HTB)
#define PG8_STAGE(bufoff, gbase, voff) do { _Pragma("unroll") for (int _i = 0; _i < 2; ++_i) \
        __builtin_amdgcn_global_load_lds((const unsigned*)((const char*)(gbase) + (voff)[_i]), (PG8_LAS unsigned*)(lds + (bufoff) + ldsw + _i * 8192), 16, 0, 0); } while (0)
#define PG8_LDA(dst, b, h) do { _Pragma("unroll") for (int m = 0; m < 4; ++m) _Pragma("unroll") for (int k = 0; k < 2; ++k) dst[m][k] = *(const PG8_LAS bf16x8*)(lds + PG8_SA(b, h) + aoff + m * 2048 + k * 1024); } while (0)
#define PG8_LDB(dst, b, h) do { _Pragma("unroll") for (int n = 0; n < 2; ++n) _Pragma("unroll") for (int k = 0; k < 2; ++k) dst[n][k] = *(const PG8_LAS bf16x8*)(lds + PG8_SB(b, h) + boff + n * 2048 + k * 1024); } while (0)
#define PG8_MMA(ai, bj, At, Bt) do { __builtin_amdgcn_s_setprio(1); _Pragma("unroll") for (int m = 0; m < 4; ++m) _Pragma("unroll") for (int n = 0; n < 2; ++n) _Pragma("unroll") for (int k = 0; k < 2; ++k) \
        acc[ai][bj][m][n] = __builtin_amdgcn_mfma_f32_16x16x32_bf16(Bt[n][k], At[m][k], acc[ai][bj][m][n], 0, 0, 0); __builtin_amdgcn_s_setprio(0); } while (0)
#define PG8_WAIT_V(n) asm volatile("s_waitcnt vmcnt(" #n ")" ::: "memory")
#define PG8_WAIT_L(n) asm volatile("s_waitcnt lgkmcnt(" #n ")" ::: "memory")
#define PG8_BAR __builtin_amdgcn_s_barrier()
#define PG8_SCHED __builtin_amdgcn_sched_barrier(0)
    Unit cur, nxt; int ui = 0;
    if (!S.next(0, cur)) return;
    f32x4 acc[2][2][4][2];
#pragma unroll
    for (int a = 0; a < 2; ++a)
#pragma unroll
        for (int b = 0; b < 2; ++b)
#pragma unroll
            for (int m = 0; m < 4; ++m)
#pragma unroll
                for (int n = 0; n < 2; ++n) acc[a][b][m][n] = (f32x4){0.f, 0.f, 0.f, 0.f};
    bf16x8 At[4][2], B0[2][2], B1[2][2];
    const char* cA = (const char*)g.A + (size_t)cur.pm * tstepA; const char* cB = (const char*)g.Bt + (size_t)cur.pn * tstep;
    S.a_ready(cur);
    if constexpr (SP2) {
        PG8_STAGE(PG8_SB(0, 0), cB, voffB); PG8_STAGE(PG8_SB(0, 1), cB + hstep, voffB); PG8_STAGE(PG8_SA(0, 0), cA, voffA); PG8_STAGE(PG8_SA(0, 1), cA + hstepA, voffA);
        if (wr == 1) PG8_BAR;
        PG8_WAIT_V(2); PG8_BAR;
        PG8_STAGE(PG8_SB(1, 0), cB + kstep, voffB); PG8_STAGE(PG8_SA(1, 0), cA + kstep, voffA); PG8_STAGE(PG8_SB(1, 1), cB + hstep + kstep, voffB);
        PG8_WAIT_V(6); PG8_BAR;
    } else {
        PG8_STAGE(PG8_SB(0, 0), cB, voffB); PG8_STAGE(PG8_SA(0, 0), cA, voffA); PG8_STAGE(PG8_SB(0, 1), cB + hstep, voffB); PG8_STAGE(PG8_SA(0, 1), cA + hstepA, voffA);
        if (wr == 1) PG8_BAR;
        PG8_WAIT_V(4); PG8_BAR;
        PG8_STAGE(PG8_SB(1, 0), cB + kstep, voffB); PG8_STAGE(PG8_SA(1, 0), cA + kstep, voffA); PG8_STAGE(PG8_SB(1, 1), cB + hstep + kstep, voffB);
        PG8_WAIT_V(6); PG8_BAR;
    }
    for (;;) {
        const bool has_next = S.next(ui + 1, nxt);
        const char* nA = has_next ? (const char*)g.A + (size_t)nxt.pm * tstepA : cA; const char* nB = has_next ? (const char*)g.Bt + (size_t)nxt.pn * tstep : cB;
        for (int t = 0; t < nt; t += 2) {
            if constexpr (Epi::MID) { if (t == E.kmid) E.mid(acc, cur, wr, wc, fr, fq); }
            const bool last = (t == nt - 2);
            const char* a1 = cA + (size_t)(t + 1) * kstep;
            const char* a2 = last ? nA : cA + (size_t)(t + 2) * kstep; const char* b2 = last ? nB : cB + (size_t)(t + 2) * kstep;
            const char* a3 = a2 + kstep; const char* b3 = b2 + kstep;
            if (last && has_next) S.a_ready(nxt);
            if constexpr (SP2) {
            const int relax = __builtin_amdgcn_readfirstlane(((t == 0) && (ui > 0)) ? 1 : 0);
            PG8_LDB(B0, 0, 0); PG8_LDB(B1, 0, 1); PG8_SCHED; PG8_LDA(At, 0, 0); PG8_STAGE(PG8_SA(1, 1), a1 + hstepA, voffA);
            asm volatile("s_cmp_eq_u32 %0, 0\n\ts_cbranch_scc1 1f\n\ts_waitcnt vmcnt(%1)\n\ts_branch 2f\n1:\n\ts_waitcnt vmcnt(8)\n2:" :: "s"(relax), "n"(8 + Epi::NSTORE) : "memory", "scc");
            PG8_WAIT_L(0); PG8_BAR; PG8_MMA(0, 0, At, B0); PG8_MMA(0, 1, At, B1); PG8_BAR; PG8_SCHED;
            PG8_LDA(At, 0, 1); PG8_STAGE(PG8_SB(0, 0), b2, voffB); PG8_STAGE(PG8_SB(0, 1), b2 + hstep, voffB); PG8_STAGE(PG8_SA(0, 0), a2, voffA);
            asm volatile("s_cmp_eq_u32 %0, 0\n\ts_cbranch_scc1 1f\n\ts_waitcnt vmcnt(%1)\n\ts_branch 2f\n1:\n\ts_waitcnt vmcnt(8)\n2:" :: "s"(relax), "n"(8 + Epi::NSTORE) : "memory", "scc");
            PG8_WAIT_L(0); PG8_BAR; PG8_MMA(1, 0, At, B0); PG8_MMA(1, 1, At, B1); PG8_BAR; PG8_SCHED;
            PG8_LDB(B0, 1, 0); PG8_LDB(B1, 1, 1); PG8_SCHED; PG8_LDA(At, 1, 0); PG8_STAGE(PG8_SA(0, 1), a2 + hstepA, voffA);
            PG8_WAIT_V(8); PG8_WAIT_L(0); PG8_BAR; PG8_MMA(0, 0, At, B0); PG8_MMA(0, 1, At, B1); PG8_BAR; PG8_SCHED;
            PG8_LDA(At, 1, 1); PG8_STAGE(PG8_SB(1, 0), b3, voffB); PG8_STAGE(PG8_SB(1, 1), b3 + hstep, voffB); PG8_STAGE(PG8_SA(1, 0), a3, voffA);
            PG8_WAIT_V(8); PG8_WAIT_L(0); PG8_BAR; PG8_MMA(1, 0, At, B0); PG8_MMA(1, 1, At, B1); PG8_BAR; PG8_SCHED;
            } else {
            PG8_LDB(B0, 0, 0); PG8_SCHED; PG8_LDA(At, 0, 0); PG8_STAGE(PG8_SA(1, 1), a1 + hstepA, voffA);
            PG8_WAIT_L(8); PG8_BAR; PG8_WAIT_L(0); PG8_MMA(0, 0, At, B0); PG8_BAR; PG8_SCHED;
            PG8_LDB(B1, 0, 1); PG8_STAGE(PG8_SB(0, 0), b2, voffB);
            PG8_BAR; PG8_WAIT_L(0); PG8_MMA(0, 1, At, B1); PG8_BAR;
            PG8_LDA(At, 0, 1); PG8_STAGE(PG8_SA(0, 0), a2, voffA);
            PG8_BAR; PG8_WAIT_L(0); PG8_MMA(1, 0, At, B0); PG8_BAR; PG8_SCHED;
            PG8_STAGE(PG8_SB(0, 1), b2 + hstep, voffB);
            PG8_WAIT_V(6); PG8_BAR; PG8_MMA(1, 1, At, B1); PG8_BAR;
            PG8_LDB(B0, 1, 0); PG8_SCHED; PG8_LDA(At, 1, 0); PG8_STAGE(PG8_SA(0, 1), a2 + hstepA, voffA);
            PG8_WAIT_L(8); PG8_BAR; PG8_WAIT_L(0); PG8_MMA(0, 0, At, B0); PG8_BAR; PG8_SCHED;
            PG8_LDB(B1, 1, 1); PG8_STAGE(PG8_SB(1, 0), b3, voffB);
            PG8_BAR; PG8_WAIT_L(0); PG8_MMA(0, 1, At, B1); PG8_BAR;
            PG8_LDA(At, 1, 1); PG8_STAGE(PG8_SA(1, 0), a3, voffA);
            PG8_BAR; PG8_WAIT_L(0); PG8_MMA(1, 0, At, B0); PG8_BAR; PG8_SCHED;
            PG8_STAGE(PG8_SB(1, 1), b3 + hstep, voffB);
            PG8_WAIT_V(6); PG8_BAR; PG8_MMA(1, 1, At, B1); PG8_BAR;
            }
        }
        if constexpr (ALIGN_EPI) { if (wr == 0) PG8_BAR; }
        if constexpr (!Epi::AFTER_DRAIN) { E(acc, cur, wr, wc, fr, fq); S.done(cur); }
        if (!has_next) break;
#pragma unroll
        for (int a = 0; a < 2; ++a)
#pragma unroll
            for (int b = 0; b < 2; ++b)
#pragma unroll
                for (int m = 0; m < 4; ++m)
#pragma unroll
                    for (int n = 0; n < 2; ++n) acc[a][b][m][n] = (f32x4){0.f, 0.f, 0.f, 0.f};
        cur = nxt; cA = nA; cB = nB; ++ui;
        if constexpr (ALIGN_EPI) { if (wr == 1) PG8_BAR; }
    }
    PG8_WAIT_V(0);
    if constexpr (!ALIGN_EPI) { if (wr == 0) PG8_BAR; }
    PG8_BAR;
    if constexpr (Epi::AFTER_DRAIN) { E.fused(acc, cur, wr, wc, fr, fq, lds, wid, lane); S.done(cur); }
#undef PG8_SA
#undef PG8_SB
#undef PG8_STAGE
#undef PG8_LDA
#undef PG8_LDB
#undef PG8_MMA
#undef PG8_WAIT_V
#undef PG8_WAIT_L
#undef PG8_BAR
#undef PG8_SCHED
}
}

constexpr int NWAVES = 8;
constexpr int BATCH = 4, SEQ = 4096, DM = 2048, M = BATCH * SEQ, DFF = 5632, NIN = 8704;
constexpr int GATE_COL = 4608;
constexpr float RMS_EPS = 1e-6f;
#ifndef MK_MULTI
#define MK_MULTI 0
#endif
constexpr int N_PHASES = 12;
#ifndef PG8_SP2
#define PG8_SP2 true
#endif
#ifndef PG8_ALIGN
#define PG8_ALIGN true
#endif

constexpr size_t MiB = 1u << 20;
constexpr size_t WS_BAR = 4096, WS_BAR_BYTES = 16384;
constexpr size_t WS_RS = 65536;
constexpr size_t WS_W = 1 * MiB;
constexpr size_t WS_XN = 67 * MiB;
constexpr size_t WS_F = 131 * MiB;
constexpr size_t WS_R1 = 195 * MiB;
constexpr size_t WS_END = 467 * MiB;
constexpr size_t W_FFN_IN = 0, W_FFN_OUT = 44 * MiB;
constexpr size_t W_MIX_IN = 0, W_MIX_UP = 34 * MiB, W_MIX_OUT = 42 * MiB;

constexpr int RING_BYTES = 131072;
constexpr int LDS_BYTES = 147456;

#define GAS __attribute__((address_space(1)))
#define LAS __attribute__((address_space(3)))
typedef unsigned short bf16;
typedef unsigned v4u __attribute__((ext_vector_type(4)));
typedef unsigned v2u __attribute__((ext_vector_type(2)));
typedef float f32x4 __attribute__((ext_vector_type(4)));
typedef float f32x16 __attribute__((ext_vector_type(16)));
typedef short bf16x8 __attribute__((ext_vector_type(8)));
typedef short v4i16_t __attribute__((ext_vector_type(4)));
#define LDS_WAIT() asm volatile("s_waitcnt lgkmcnt(0)" ::: "memory")

__device__ __forceinline__ unsigned f2bf(float f) { unsigned u = __builtin_bit_cast(unsigned, f); return (u + 0x7fffu + ((u >> 16) & 1u)) >> 16; }
__device__ __forceinline__ unsigned pk2(float lo, float hi) { return f2bf(lo) | (f2bf(hi) << 16); }
__device__ __forceinline__ float wave_sum(float v) {
#pragma unroll
    for (int o = 1; o < 64; o <<= 1) v += __shfl_xor(v, o);
    return v;
}

__device__ __forceinline__ void tr_item(const float* W, int N, bf16* WT, int Kdst, int kdst0, bool swiglu, const float* gain, LAS float* scr, int item, int lane) {
    const int nblk = N / 32, kb = item / nblk, nb = item % nblk, k0 = 64 * kb, nd0 = 32 * nb;
    int ns0 = nd0;
    if (swiglu) { const int t = nd0 >> 8, w = nd0 & 255; ns0 = (w < 128) ? t * 128 + w : (N / 2) + t * 128 + (w - 128); }
    float wv[32];
    const float* wp = W + (size_t)(k0 + (lane >> 5)) * N + ns0 + (lane & 31);
#pragma unroll
    for (int i = 0; i < 32; ++i) wv[i] = __builtin_nontemporal_load(wp + (size_t)(2 * i) * N);
#pragma unroll
    for (int i = 0; i < 32; ++i) scr[(2 * i + (lane >> 5)) * 33 + (lane & 31)] = wv[i];
    LDS_WAIT(); asm volatile("" ::: "memory");
    const int c = lane & 7;
    f32x4 g0 = (f32x4){1.f, 1.f, 1.f, 1.f}, g1 = g0;
    if (gain) { g0 = *(const f32x4*)(gain + k0 + 8 * c); g1 = *(const f32x4*)(gain + k0 + 8 * c + 4); }
#pragma unroll
    for (int j = 0; j < 4; ++j) { const int n = (lane >> 3) + 8 * j; const LAS float* s = scr + (8 * c) * 33 + n;
        v4u o; o.x = pk2(s[0 * 33] * g0.x, s[1 * 33] * g0.y); o.y = pk2(s[2 * 33] * g0.z, s[3 * 33] * g0.w); o.z = pk2(s[4 * 33] * g1.x, s[5 * 33] * g1.y); o.w = pk2(s[6 * 33] * g1.z, s[7 * 33] * g1.w);
        *(GAS v4u*)(WT + (size_t)(nd0 + n) * Kdst + kdst0 + k0 + 8 * c) = o; }
    LDS_WAIT(); asm volatile("" ::: "memory");
}
struct TrMat { const float* W; int Ksrc, N; bf16* WT; int Kdst, kdst0; bool swiglu; const float* gain; };
__device__ __forceinline__ void tr_run(const TrMat& t, LAS float* scr, int gw, int NGW, int lane, int part = 0, int nparts = 1) {
    const int items = (t.Ksrc / 64) * (t.N / 32), i0 = (int)((long)items * part / nparts), i1 = (int)((long)items * (part + 1) / nparts);
    for (int it = i0 + gw; it < i1; it += NGW) tr_item(t.W, t.N, t.WT, t.Kdst, t.kdst0, t.swiglu, t.gain, scr, it, lane);
}

__device__ __forceinline__ void tr_run_dyn(const TrMat& t, LAS float* scr, unsigned* ctr, volatile LAS unsigned* slot, int wave, int lane, int tid, int part, int nparts, int span) {
    const int items = (t.Ksrc / 64) * (t.N / 32), i0 = (int)((long)items * part / nparts), i1 = (int)((long)items * (part + span) / nparts);
    unsigned nxt = 0u;
    if (tid == 0) nxt = __hip_atomic_fetch_add(ctr, 8u, __ATOMIC_RELAXED, __HIP_MEMORY_SCOPE_AGENT);
    for (;;) {
        if (tid == 0) slot[0] = nxt;
        __syncthreads();
        const int base = i0 + (int)slot[0];
        if (base >= i1) break;
        if (tid == 0) nxt = __hip_atomic_fetch_add(ctr, 8u, __ATOMIC_RELAXED, __HIP_MEMORY_SCOPE_AGENT);
        const int it = base + wave;
        if (it < i1) tr_item(t.W, t.N, t.WT, t.Kdst, t.kdst0, t.swiglu, t.gain, scr, it, lane);
        __syncthreads();
    }
    __syncthreads();
}

__device__ __forceinline__ void norm_rows(int gw, int NGW, int lane, const float* hx, const bf16* hb_in, const bf16* f, const float* gpost, float wres, bf16* hb_out, float* rs, float* fout) {
    for (int m = gw; m < M; m += NGW) {
        f32x4 v[8];
        if (hx) { const GAS f32x4* hr = (const GAS f32x4*)(hx + (size_t)m * DM) + lane;
#pragma unroll
            for (int j = 0; j < 8; ++j) v[j] = __builtin_nontemporal_load(hr + 64 * j);
        } else { const GAS v2u* hr = (const GAS v2u*)(hb_in + (size_t)m * DM) + lane;
            const float un = 1.0f / rs[m];
#pragma unroll
            for (int j = 0; j < 8; ++j) { const v2u w = __builtin_nontemporal_load(hr + 64 * j); v[j] = (f32x4){__uint_as_float(w.x << 16), __uint_as_float(w.x & 0xffff0000u), __uint_as_float(w.y << 16), __uint_as_float(w.y & 0xffff0000u)} * un; }
        }
        if (f) {
            const GAS v2u* fr = (const GAS v2u*)(f + (size_t)m * DM) + lane;
            f32x4 fv[8]; float ss = 0.f;
#pragma unroll
            for (int j = 0; j < 8; ++j) { const v2u w = __builtin_nontemporal_load(fr + 64 * j); fv[j] = (f32x4){__uint_as_float(w.x << 16), __uint_as_float(w.x & 0xffff0000u), __uint_as_float(w.y << 16), __uint_as_float(w.y & 0xffff0000u)};
                ss += (fv[j].x * fv[j].x + fv[j].y * fv[j].y) + (fv[j].z * fv[j].z + fv[j].w * fv[j].w); }
            const float rstd = wres * __builtin_amdgcn_rsqf(wave_sum(ss) * (1.f / DM) + RMS_EPS);
#pragma unroll
            for (int j = 0; j < 8; ++j) { const f32x4 g = *((const GAS f32x4*)gpost + lane + 64 * j); v[j] = v[j] + fv[j] * rstd * g; }
        }
        if (fout) { GAS f32x4* ho = (GAS f32x4*)(fout + (size_t)m * DM) + lane;
#pragma unroll
            for (int j = 0; j < 8; ++j) __builtin_nontemporal_store(v[j], ho + 64 * j);
        } else {
            float ss = 0.f;
#pragma unroll
            for (int j = 0; j < 8; ++j) ss += (v[j].x * v[j].x + v[j].y * v[j].y) + (v[j].z * v[j].z + v[j].w * v[j].w);
            const float rstd = __builtin_amdgcn_rsqf(wave_sum(ss) * (1.f / DM) + RMS_EPS);
            if (lane == 0) rs[m] = rstd;
            GAS v2u* o8 = (GAS v2u*)(hb_out + (size_t)m * DM) + lane;
#pragma unroll
            for (int j = 0; j < 8; ++j) { const f32x4 y = v[j] * rstd; v2u w; w.x = pk2(y.x, y.y); w.y = pk2(y.z, y.w); o8[64 * j] = w; }
        }
    }
}

namespace att {
constexpr int KROWB = 272, VROWB = 320, KT = 32 * KROWB, VT = 32 * VROWB, STG = KT + VT, RPB_OFF = 2 * STG, QUADB = RPB_OFF + 2048;
static_assert(2 * QUADB <= RING_BYTES, "attention LDS");
constexpr float LOG2E = 1.4426950408889634f;
constexpr float C1 = 0.08838834764831845f * LOG2E;
__device__ __forceinline__ int crow(int r, int hi) { return (r & 3) + 8 * (r >> 2) + 4 * hi; }
typedef float f32x2_t __attribute__((ext_vector_type(2))); typedef __bf16 bf16x2_t __attribute__((ext_vector_type(2)));
__device__ __forceinline__ unsigned cvtpk(float lo, float hi) { f32x2_t v = {lo, hi}; bf16x2_t b = __builtin_convertvector(v, bf16x2_t); return __builtin_bit_cast(unsigned, b); }
__device__ __forceinline__ v4i16_t vtr(const LAS unsigned char* p) { return __builtin_amdgcn_ds_read_tr16_b64_v4i16((LAS v4i16_t*)p); }

template <int MODE>
__device__ __forceinline__ void attn_pair(LAS unsigned char* lds, const bf16* QKV, bf16* Y, const float* aux, int pu, int tid) {
    const int lane = tid & 63, wave = __builtin_amdgcn_readfirstlane(tid >> 6), quad = wave >> 2, wq = wave & 3, l32 = lane & 31, hi = lane >> 5, tq = tid & 255;
    LAS unsigned char* Ql = lds + ((MODE == 0) ? 0 : quad * QUADB); LAS float* rpbl = (LAS float*)(lds + quad * QUADB + RPB_OFF);
    const int hp = pu & 3, blk = (pu >> 2) & 31, b = pu >> 7, h = 2 * hp + quad;
    int qcol, kcol, vcol, ycol, qtok, t0 = 0, t1;
    int qloc = 0; float slope2 = 0.f;
    int kr0 = 0, kc0 = 0, lo_r = 0, lo_c = 0, RC = 0;
    float m_run, l_run;
    if (MODE == 0) {
        const int kvh = h >> 2; qcol = h * 128; kcol = 1024 + kvh * 128; vcol = 1280 + kvh * 128; ycol = h * 128;
        qloc = 32 * wq + l32; qtok = b * SEQ + blk * 128 + qloc;
        t0 = (blk == 0) ? 4 : 0; t1 = (blk == 31) ? 8 : 12;
        slope2 = __builtin_amdgcn_exp2f(-(float)(h + 1)) * LOG2E;
        m_run = aux[h] * LOG2E; l_run = (hi == 0) ? 1.f : 0.f;
    } else {
        const int bi = blk >> 2, bj = blk & 3;
        qcol = 1536 + h * 128; kcol = 2560 + h * 128; vcol = 3584 + h * 128; ycol = 1024 + h * 128;
        const int qrow = 8 * bi + 2 * wq + (l32 >> 4), qc = 16 * bj + (l32 & 15); qtok = b * SEQ + qrow * 64 + qc;
        kr0 = min(max(8 * bi - 4, 0), 49); kc0 = min(max(16 * bj - 8, 0), 33);
        lo_r = min(max(qrow - 4, 0), 56) - kr0; lo_c = min(max(qc - 8, 0), 48) - kc0;
        RC = (kr0 - qrow + 7) * 31 + (kc0 - qc + 15);
        t1 = 15;
        m_run = -1e30f; l_run = 0.f;
    }
    __syncthreads();
    if (MODE == 1) { for (int idx = tq; idx < 465; idx += 256) rpbl[idx] = aux[h * 465 + idx] * LOG2E; }
    bf16x8 qf[8];
    { const bf16* qp = QKV + (size_t)qtok * NIN + qcol + 8 * hi;
#pragma unroll
      for (int ds = 0; ds < 8; ++ds) qf[ds] = *(const bf16x8*)(qp + 16 * ds); }
    f32x16 o[4];
#pragma unroll
    for (int d = 0; d < 4; ++d)
#pragma unroll
        for (int r = 0; r < 16; ++r) o[d][r] = 0.f;
    constexpr int NST = (MODE == 0) ? 1 : 2;
    const int ch = tq & 15, klb = (MODE == 0) ? (tid >> 4) : (tq >> 4);
    v4u kreg[NST], vreg[NST];
#define ATT_LOAD(tt) do { _Pragma("unroll") for (int i = 0; i < NST; ++i) { const int kl = klb + 16 * i; int tok; \
        if (MODE == 0) { const int pos = blk * 128 - 128 + 32 * (tt) + kl; tok = b * SEQ + min(max(pos, 0), SEQ - 1); } \
        else { tok = b * SEQ + (kr0 + (tt)) * 64 + kc0 + min(kl, 30); } \
        const bf16* rp = QKV + (size_t)tok * NIN + ch * 8; kreg[i] = *(const v4u*)(rp + kcol); vreg[i] = *(const v4u*)(rp + vcol); } } while (0)
#define ATT_WRITE(stg) do { _Pragma("unroll") for (int i = 0; i < NST; ++i) { const int kl = klb + 16 * i; \
        *(LAS v4u*)(Ql + (stg) * STG + kl * KROWB + ch * 16) = kreg[i]; *(LAS v4u*)(Ql + (stg) * STG + KT + kl * VROWB + ch * 16) = vreg[i]; } } while (0)
    ATT_LOAD(t0);
    ATT_WRITE(0);
    __syncthreads();
    const int koff = l32 * KROWB + hi * 16;
    const int voff = KT + (4 * hi + ((lane >> 2) & 3)) * VROWB + (16 * ((lane >> 4) & 1) + 4 * (lane & 3)) * 2;
    int cur = 0;
    for (int tt = t0; tt < t1; ++tt) {
        const bool more = tt + 1 < t1;
        if (more) ATT_LOAD(tt + 1);
        const LAS unsigned char* kaddr = Ql + cur * STG + koff;
        const LAS unsigned char* vaddr = Ql + cur * STG + voff;
        bool need_lane;
        if (MODE == 0) need_lane = (32 * tt + 31 >= qloc) && (32 * tt <= qloc + 256); else need_lane = (unsigned)(tt - lo_r) < 8u;
        if (__builtin_amdgcn_ballot_w64(need_lane) != 0ull) {
        f32x16 p0;
#pragma unroll
        for (int r = 0; r < 16; ++r) p0[r] = 0.f;
#pragma unroll
        for (int ds = 0; ds < 8; ++ds) {
            const bf16x8 k0 = *(const LAS bf16x8*)(kaddr + ds * 32);
            p0 = __builtin_amdgcn_mfma_f32_32x32x16_bf16(k0, qf[ds], p0, 0, 0, 0);
        }
        const float NEG = -INFINITY;
        float mx = NEG;
#pragma unroll
        for (int r = 0; r < 16; ++r) {
            const int kl = crow(r, hi);
            if (MODE == 0) {
                const int kk0 = 32 * tt + kl;
                const int d0 = qloc + 128 - kk0;
                const int a0 = d0 < 0 ? -d0 : d0;
                const int pos0 = blk * 128 - 128 + kk0;
                const bool v0 = (a0 <= 128) && ((unsigned)pos0 < (unsigned)SEQ);
                p0[r] = v0 ? (p0[r] * C1 - slope2 * (float)a0) : NEG;
            } else {
                const bool v0 = ((unsigned)(kl - lo_c) < 16u) && ((unsigned)(tt - lo_r) < 8u);
                const int i0 = tt * 31 + kl + RC;
                const float b0 = rpbl[v0 ? i0 : 0];
                p0[r] = v0 ? (p0[r] * C1 + b0) : NEG;
            }
            mx = fmaxf(mx, p0[r]);
        }
        mx = fmaxf(mx, __shfl_xor(mx, 32));
        const float m_new = fmaxf(m_run, mx);
        const float alpha = __builtin_amdgcn_exp2f(m_run - m_new);
        m_run = m_new;
        float ps = 0.f;
#pragma unroll
        for (int r = 0; r < 16; ++r) { p0[r] = __builtin_amdgcn_exp2f(p0[r] - m_new); ps += p0[r]; }
        l_run = l_run * alpha + ps;
#pragma unroll
        for (int d = 0; d < 4; ++d)
#pragma unroll
            for (int r = 0; r < 16; ++r) o[d][r] *= alpha;
        bf16x8 pf[2];
#pragma unroll
        for (int i = 0; i < 2; ++i) {
            v4u w0;
            w0.x = cvtpk(p0[8 * i + 0], p0[8 * i + 1]); w0.y = cvtpk(p0[8 * i + 2], p0[8 * i + 3]); w0.z = cvtpk(p0[8 * i + 4], p0[8 * i + 5]); w0.w = cvtpk(p0[8 * i + 6], p0[8 * i + 7]);
            pf[i] = __builtin_bit_cast(bf16x8, w0);
        }
#pragma unroll
        for (int d = 0; d < 4; ++d)
#pragma unroll
            for (int i = 0; i < 2; ++i) {
                const LAS unsigned char* vp = vaddr + (16 * i) * VROWB + 64 * d;
                const v4i16_t lo = vtr(vp), hh = vtr(vp + 8 * VROWB);
                const bf16x8 vf = (bf16x8){lo[0], lo[1], lo[2], lo[3], hh[0], hh[1], hh[2], hh[3]};
                o[d] = __builtin_amdgcn_mfma_f32_32x32x16_bf16(vf, pf[i], o[d], 0, 0, 0);
            }
        }
        if (more) ATT_WRITE(cur ^ 1);
        __syncthreads();
        cur ^= 1;
    }
#undef ATT_LOAD
#undef ATT_WRITE
    l_run += __shfl_xor(l_run, 32);
    const float inv = 1.0f / l_run;
    bf16* yq = Y + (size_t)qtok * DM + ycol + 8 * hi;
#pragma unroll
    for (int d = 0; d < 4; ++d)
#pragma unroll
        for (int ap = 0; ap < 2; ++ap) { const int a = 2 * ap;
            const unsigned ax = cvtpk(o[d][4 * a] * inv, o[d][4 * a + 1] * inv), ay = cvtpk(o[d][4 * a + 2] * inv, o[d][4 * a + 3] * inv);
            const unsigned bx_ = cvtpk(o[d][4 * a + 4] * inv, o[d][4 * a + 5] * inv), by_ = cvtpk(o[d][4 * a + 6] * inv, o[d][4 * a + 7] * inv);
            const auto rx = __builtin_amdgcn_permlane32_swap(ax, bx_, false, false), ry = __builtin_amdgcn_permlane32_swap(ay, by_, false, false);
            v4u w; w.x = rx[0]; w.y = ry[0]; w.z = rx[1]; w.w = ry[1];
            *(v4u*)(yq + 32 * d + 16 * ap) = w; }
}
}

typedef GAS unsigned gu32;
#define RLX_AGENT __ATOMIC_RELAXED, __HIP_MEMORY_SCOPE_AGENT
#define XB_TMO      128
#define XB_XCNT(j)  (256  + 64 * (j))
#define XB_XSUB(j)  (1280 + 64 * (j))
#define XB_XGEN(j)  (2304 + 64 * (j))
#define XB_TOP      3328
#define XB_TOPGEN   3392
#define XCD_BAR_WORDS 3456
#define XB_SPIN_CAP (1u << 18)

__device__ __forceinline__ unsigned xb_ld(unsigned* p)              { return __hip_atomic_load(p, __ATOMIC_RELAXED, __HIP_MEMORY_SCOPE_AGENT); }
__device__ __forceinline__ unsigned xb_add(unsigned* p, unsigned v) { return __hip_atomic_fetch_add(p, v, __ATOMIC_RELAXED, __HIP_MEMORY_SCOPE_AGENT); }
__device__ __forceinline__ unsigned xb_xcc_id() { return (unsigned)__builtin_amdgcn_s_getreg((3 << 11) | 20) & 0xFu; }
#define XB_SPIN(cond, bar) do { unsigned _sp = 0; while (cond) { __builtin_amdgcn_s_sleep(1); \
    if ((++_sp & 255u) == 0u) { if (xb_ld(&(bar)[XB_TMO])) break; if (_sp > XB_SPIN_CAP) { atomicAdd(&(bar)[XB_TMO], 1u); break; } } } } while (0)

struct XcdBarrier {
    unsigned* bar; unsigned x;
    volatile LAS unsigned* st;
};

__device__ __forceinline__ XcdBarrier xcd_barrier_post(unsigned* bar, volatile LAS unsigned* st) {
    XcdBarrier b; b.bar = bar; b.x = xb_xcc_id(); b.st = st;
    if (threadIdx.x == 0) (void)xb_add(&bar[XB_XCNT(b.x)], 1u);
    return b;
}
__device__ __forceinline__ void xcd_barrier_complete(unsigned* bar, unsigned x, unsigned& nloc, unsigned& nx) {
    const unsigned G = gridDim.x * gridDim.y * gridDim.z;
    unsigned sum, cnt, mine, sp = 0u;
    for (;;) {
        sum = 0u; cnt = 0u; mine = 0u;
#pragma unroll
        for (unsigned j = 0; j < 16; ++j) { const unsigned c = xb_ld(&bar[XB_XCNT(j)]); sum += c; cnt += (c > 0u) ? 1u : 0u; mine = (j == x) ? c : mine; }
        if (sum == G) break;
        __builtin_amdgcn_s_sleep(1);
        if ((++sp & 255u) == 0u) { if (xb_ld(&bar[XB_TMO])) break; if (sp > XB_SPIN_CAP) { atomicAdd(&bar[XB_TMO], 1u); break; } }
    }
    nloc = mine > 0u ? mine : 1u; nx = cnt > 0u ? cnt : 1u;
}

__device__ __forceinline__ void xcd_barrier(const XcdBarrier& b) {
    asm volatile("s_waitcnt vmcnt(0)" ::: "memory");
    __syncthreads();
    if (threadIdx.x == 0) {
        unsigned* bar = b.bar;
        __builtin_amdgcn_s_waitcnt(0);
        unsigned nloc = b.st[0], nx = b.st[1];
        if (nloc == 0u) { xcd_barrier_complete(bar, b.x, nloc, nx); b.st[0] = nloc; b.st[1] = nx; }
        const unsigned old = xb_add(&bar[XB_XSUB(b.x)], 1u);
        const unsigned gen = old / nloc;
        if (old + 1u == (gen + 1u) * nloc) {
            __builtin_amdgcn_fence(__ATOMIC_RELEASE, "agent");
            asm volatile("s_waitcnt vmcnt(0)" ::: "memory");
            const unsigned og = xb_add(&bar[XB_TOP], 1u);
            const unsigned tg = og / nx;
            if (og + 1u == (tg + 1u) * nx) xb_add(&bar[XB_TOPGEN], 1u);
            else XB_SPIN(xb_ld(&bar[XB_TOPGEN]) == tg, bar);
            __builtin_amdgcn_fence(__ATOMIC_ACQUIRE, "agent");
            xb_add(&bar[XB_XGEN(b.x)], 1u);
            asm volatile("s_waitcnt vmcnt(0)" ::: "memory");
        } else {
            XB_SPIN(xb_ld(&bar[XB_XGEN(b.x)]) == gen, bar);
            __builtin_amdgcn_fence(__ATOMIC_ACQUIRE, "agent");
            asm volatile("s_waitcnt vmcnt(0)" ::: "memory");
        }
    }
    __syncthreads();
}

struct Args { const float* in[18]; float* out; unsigned char* ws; int ph_lo, ph_hi; };
__global__ void __launch_bounds__(NWAVES * 64, 2) mk_fwd(Args args) {
    extern __shared__ __attribute__((aligned(16))) unsigned char lds_raw[];
    LAS unsigned char* lds = (LAS unsigned char*)lds_raw;
    const int tid = threadIdx.x, lane = tid & 63, wave = __builtin_amdgcn_readfirstlane(tid >> 6);
    const int G = gridDim.x, bx = blockIdx.x;
    const int gw = bx * NWAVES + wave, NGW = G * NWAVES;
    unsigned char* ws = args.ws;
    const float* x = args.in[0];
    float* out = args.out;
    float* RS = (float*)(ws + WS_RS); bf16* WMIX = (bf16*)((unsigned char*)out + 66 * MiB);     bf16* W2 = (bf16*)out;
    bf16* WREG = (bf16*)(ws + WS_W); bf16* XN = (bf16*)(ws + WS_XN); bf16* FB = (bf16*)(ws + WS_F); bf16* R1 = (bf16*)(ws + WS_R1);
    LAS float* scr = (LAS float*)(lds + wave * 16384);
    unsigned* qctr = (unsigned*)(ws + WS_BAR + 14336);
    volatile LAS unsigned* qslot = (volatile LAS unsigned*)(lds + RING_BYTES + 96);
    const int lo = args.ph_lo, hi = args.ph_hi;
    volatile LAS unsigned* xst = (volatile LAS unsigned*)(lds + RING_BYTES + 64);
    if (tid < 2) xst[tid] = 0u;
    __syncthreads();
    if (args.ph_lo < 0) cg::this_grid().sync();
    XcdBarrier xbar; xbar.bar = (unsigned*)(ws + WS_BAR); xbar.x = 0; xbar.st = xst;
#if !MK_MULTI
    xbar = xcd_barrier_post((unsigned*)(ws + WS_BAR), xst);
#endif
#ifndef PHASE_MASK
#define PHASE_MASK 0xFFF
#endif
#define IN(k) (((PHASE_MASK >> (k)) & 1) && lo <= (k) && (k) < hi)
#ifndef PROBE_REP_MASK
#define PROBE_REP_MASK 0
#endif
#ifndef PROBE_SYNC_REP
#define PROBE_SYNC_REP 1
#endif
#define NREP(k) (1 + ((PROBE_REP_MASK >> (k)) & 1))
#define REP(k) for (int rep_ = 0; rep_ < 1 + ((PROBE_REP_MASK >> (k)) & 1); ++rep_)
#if MK_MULTI
#define SEAM(k) do { } while (0)
#else
#define SEAM(k) do { if (IN(k) && IN((k) + 1)) { for (int sr_ = 0; sr_ < PROBE_SYNC_REP; ++sr_) { xcd_barrier(xbar); } } } while (0)
#endif
    if (IN(0)) REP(0) {
        { TrMat t{args.in[2], DM, 2 * DFF, (bf16*)((unsigned char*)WREG + W_FFN_IN), DM, 0, true, args.in[1]}; tr_run(t, scr, gw, NGW, lane); }
        norm_rows(gw, NGW, lane, x, nullptr, nullptr, nullptr, 0.f, XN, RS, nullptr);
        __syncthreads();
    }
    SEAM(0);
    if (IN(1)) {
        pg8::Gemm g{XN, (const bf16*)((unsigned char*)WREG + W_FFN_IN), M, 2 * DFF, DM}; pg8::StaticOrder S; S.init(M, 2 * DFF, G, bx, NREP(1));
        pg8::EpiSwiGLU E{R1, DFF};
        pg8::gemm_phase<pg8::EpiSwiGLU, pg8::StaticOrder, PG8_ALIGN, PG8_SP2>(lds, g, S, E);
        { TrMat t{args.in[3], DFF, DM, (bf16*)((unsigned char*)WREG + W_FFN_OUT), DFF, 0, false, nullptr}; tr_run_dyn(t, scr, qctr + 0, qslot, wave, lane, tid, 0, 1, 1); }
        { TrMat t{args.in[6], DM, NIN, (bf16*)((unsigned char*)WMIX + W_MIX_IN), DM, 0, false, args.in[5]}; tr_run_dyn(t, scr, qctr + 16, qslot, wave, lane, tid, 0, 4, 1); }
        __syncthreads();
    }
    SEAM(1);
    if (IN(2)) {
        pg8::Gemm g{R1, (const bf16*)((unsigned char*)WREG + W_FFN_OUT), M, DM, DFF}; pg8::StaticOrder S; S.init(M, DM, G, bx, NREP(2));
        pg8::EpiStore E{FB, DM};
        pg8::gemm_phase<pg8::EpiStore, pg8::StaticOrder, PG8_ALIGN, PG8_SP2>(lds, g, S, E);
        { TrMat t{args.in[6], DM, NIN, (bf16*)((unsigned char*)WMIX + W_MIX_IN), DM, 0, false, args.in[5]};
          tr_run_dyn(t, scr, qctr + 32, qslot, wave, lane, tid, 1, 4, 3); }
        if (G != 256) {
            { TrMat t{args.in[10], 1024, DM, (bf16*)((unsigned char*)WMIX + W_MIX_UP), DM, 0, false, nullptr}; tr_run(t, scr, gw, NGW, lane); }
            { TrMat t{args.in[11], 1024, DM, (bf16*)((unsigned char*)WMIX + W_MIX_UP), DM, 1024, false, nullptr}; tr_run(t, scr, gw, NGW, lane); }
            { TrMat t{args.in[12], DM, DM, (bf16*)((unsigned char*)WMIX + W_MIX_OUT), DM, 0, false, nullptr}; tr_run(t, scr, gw, NGW, lane); }
        }
        __syncthreads();
    }
    SEAM(2);
    if (IN(3)) REP(3) {
        norm_rows(gw, NGW, lane, nullptr, XN, FB, args.in[4], 0.5f, XN, RS, nullptr);
        __syncthreads();
    }
    SEAM(3);
    if (IN(4)) {
        pg8::Gemm g{XN, (const bf16*)((unsigned char*)WMIX + W_MIX_IN), M, NIN, DM}; pg8::StaticOrder S; S.init(M, NIN, G, bx, NREP(4));
        pg8::EpiInProj E{R1, NIN, args.in[7], GATE_COL / 256};
        pg8::gemm_phase<pg8::EpiInProj, pg8::StaticOrder, PG8_ALIGN, PG8_SP2>(lds, g, S, E);
        if (G == 256 && bx >= 128) {
            const int gw2 = (bx - 128) * NWAVES + wave, NGW2 = 128 * NWAVES;
            { TrMat t{args.in[10], 1024, DM, (bf16*)((unsigned char*)WMIX + W_MIX_UP), DM, 0, false, nullptr}; tr_run(t, scr, gw2, NGW2, lane); }
            { TrMat t{args.in[11], 1024, DM, (bf16*)((unsigned char*)WMIX + W_MIX_UP), DM, 1024, false, nullptr}; tr_run(t, scr, gw2, NGW2, lane); }
            { TrMat t{args.in[12], DM, DM, (bf16*)((unsigned char*)WMIX + W_MIX_OUT), DM, 0, false, nullptr}; tr_run(t, scr, gw2, NGW2, lane); }
            { TrMat t{args.in[15], DM, 2 * DFF, (bf16*)((unsigned char*)W2 + W_FFN_IN), DM, 0, true, args.in[14]}; tr_run(t, scr, gw2, NGW2, lane); }
            __syncthreads();
        }
    }
    SEAM(4);
    if (IN(5)) {
        if (G == 256) {
            for (int k = 0; k < 4 * NREP(5); ++k) { const int pu = 64 * (bx & 7) + (bx >> 3) + 32 * (k & 1);
                if (((k >> 1) & 1) == 0) att::attn_pair<0>(lds, R1, FB, args.in[8], pu, tid);
                else att::attn_pair<1>(lds, R1, FB, args.in[9], pu, tid);
            }
        } else {
            for (int uu = bx; uu < 1024 * NREP(5); uu += G) { const int u = uu & 1023;
                if (u < 512) att::attn_pair<0>(lds, R1, FB, args.in[8], u, tid);
                else att::attn_pair<1>(lds, R1, FB, args.in[9], u - 512, tid);
            }
        }
        __syncthreads();
        if (G == 256) { TrMat t{args.in[16], DFF, DM, (bf16*)((unsigned char*)W2 + W_FFN_OUT), DFF, 0, false, nullptr}; tr_run_dyn(t, scr, qctr + 48, qslot, wave, lane, tid, 0, 3, 1); }
    }
    SEAM(5);
    if (IN(6)) {
        pg8::Gemm g{FB, (const bf16*)((unsigned char*)WMIX + W_MIX_UP), M, DM, DM}; pg8::StaticOrder S; S.init(M, DM, G, bx, NREP(6));
        pg8::EpiUp E{R1, NIN, R1, NIN, GATE_COL, GATE_COL + DM, 16};
        pg8::gemm_phase<pg8::EpiUp, pg8::StaticOrder, PG8_ALIGN, PG8_SP2>(lds, g, S, E);
        if (G == 256) { TrMat t{args.in[16], DFF, DM, (bf16*)((unsigned char*)W2 + W_FFN_OUT), DFF, 0, false, nullptr}; tr_run_dyn(t, scr, qctr + 64, qslot, wave, lane, tid, 1, 3, 1); }
    }
    SEAM(6);
    if (IN(7)) {
        pg8::Gemm g{R1, (const bf16*)((unsigned char*)WMIX + W_MIX_OUT), M, DM, DM, NIN}; pg8::StaticOrder S; S.init(M, DM, G, bx, NREP(7));
        pg8::EpiStore E{FB, DM};
        pg8::gemm_phase<pg8::EpiStore, pg8::StaticOrder, PG8_ALIGN, PG8_SP2>(lds, g, S, E);
        if (G == 256) { TrMat t{args.in[16], DFF, DM, (bf16*)((unsigned char*)W2 + W_FFN_OUT), DFF, 0, false, nullptr}; tr_run_dyn(t, scr, qctr + 80, qslot, wave, lane, tid, 2, 3, 1); }
    }
    SEAM(7);
    if (IN(8)) REP(8) {
        norm_rows(gw, NGW, lane, nullptr, XN, FB, args.in[13], 1.0f, XN, RS, nullptr);
        if (G != 256) {
            { TrMat t{args.in[15], DM, 2 * DFF, (bf16*)((unsigned char*)W2 + W_FFN_IN), DM, 0, true, args.in[14]}; tr_run(t, scr, gw, NGW, lane); }
            { TrMat t{args.in[16], DFF, DM, (bf16*)((unsigned char*)W2 + W_FFN_OUT), DFF, 0, false, nullptr}; tr_run(t, scr, gw, NGW, lane); }
        }
        __syncthreads();
    }
    SEAM(8);
    if (IN(9)) {
        pg8::Gemm g{XN, (const bf16*)((unsigned char*)W2 + W_FFN_IN), M, 2 * DFF, DM}; pg8::StaticOrder S; S.init(M, 2 * DFF, G, bx, NREP(9));
        pg8::EpiSwiGLU E{R1, DFF};
        pg8::gemm_phase<pg8::EpiSwiGLU, pg8::StaticOrder, PG8_ALIGN, PG8_SP2>(lds, g, S, E);
    }
    SEAM(9);
    if (IN(10)) {
        pg8::Gemm g{R1, (const bf16*)((unsigned char*)W2 + W_FFN_OUT), M, DM, DFF}; pg8::StaticOrder S; S.init(M, DM, G, bx, NREP(10));
        pg8::EpiStore E{FB, DM};
        pg8::gemm_phase<pg8::EpiStore, pg8::StaticOrder, PG8_ALIGN, PG8_SP2>(lds, g, S, E);
    }
    SEAM(10);
    if (IN(11)) REP(11) {
        norm_rows(gw, NGW, lane, nullptr, XN, FB, args.in[17], 0.5f, nullptr, RS, out);
    }
#undef IN
#undef SEAM
}

extern "C" void kernel_launch(void* const* d_in, const int* in_sizes, int n_in, void* d_out, int out_size, void* d_ws, size_t ws_size, hipStream_t stream) {
    static int grid = 0;
    if (grid == 0) {
        if (n_in != 18 || in_sizes[0] != M * DM || out_size != M * DM || ws_size < WS_END) { fprintf(stderr, "kernel_launch: unexpected shapes (n_in %d, in0 %d, out %d, ws %zu)\n", n_in, n_in > 0 ? in_sizes[0] : -1, out_size, ws_size); grid = -1; return; }
        int dev = 0, cus = 0, per_cu = 0;
        if (hipGetDevice(&dev) != hipSuccess || hipDeviceGetAttribute(&cus, hipDeviceAttributeMultiprocessorCount, dev) != hipSuccess) { grid = -1; return; }
        if (hipFuncSetAttribute((const void*)mk_fwd, hipFuncAttributeMaxDynamicSharedMemorySize, LDS_BYTES) != hipSuccess) { fprintf(stderr, "kernel_launch: hipFuncSetAttribute failed\n"); grid = -1; return; }
        if (hipOccupancyMaxActiveBlocksPerMultiprocessor(&per_cu, (const void*)mk_fwd, NWAVES * 64, LDS_BYTES) != hipSuccess || per_cu < 1) { fprintf(stderr, "kernel_launch: occupancy query says %d\n", per_cu); per_cu = 1; }
        (void)hipGetLastError();
        grid = cus;
    }
    if (grid < 0) return;
    Args a{};
    for (int i = 0; i < 18; ++i) a.in[i] = (const float*)d_in[i];
    a.out = (float*)d_out; a.ws = (unsigned char*)d_ws;
#if MK_MULTI
    for (int p = 0; p < N_PHASES; ++p) { a.ph_lo = p; a.ph_hi = p + 1; hipLaunchKernelGGL(mk_fwd, dim3(grid), dim3(NWAVES * 64), LDS_BYTES, stream, a); }
#else
    a.ph_lo = 0; a.ph_hi = N_PHASES;
    if (hipMemsetAsync((char*)d_ws + WS_BAR, 0, WS_BAR_BYTES, stream) != hipSuccess) { fprintf(stderr, "kernel_launch: memset of the barrier words failed\n"); return; }
    void* kargs[] = {&a};
    hipError_t e = hipLaunchCooperativeKernel((const void*)mk_fwd, dim3(grid), dim3(NWAVES * 64), kargs, LDS_BYTES, stream);
    if (e != hipSuccess) fprintf(stderr, "kernel_launch: cooperative launch failed: %s (grid %d)\n", hipGetErrorString(e), grid);
#endif
}
```
